# Optimizing an MI355X kernel written in HIP

```python
import math
import jax, jax.numpy as jnp
from jax import lax
import numpy as np

D_MODEL = 1024
BATCH = 8
SEQ = 4096
DEPTH = 2

N_MEM = 256
MIX_WIDTH = D_MODEL
ML_HEADS = 4
ML_WIDTH = MIX_WIDTH // 2
ML_HEAD_DIM = ML_WIDTH // ML_HEADS
ML_CHUNK = 64
ML_CONV = 4
SWA_HEAD_DIM = 64
SWA_WIDTH = MIX_WIDTH - ML_WIDTH
SWA_HEADS = SWA_WIDTH // SWA_HEAD_DIM
SWA_KV_HEADS = SWA_HEADS // 4
SWA_GROUP = SWA_HEADS // SWA_KV_HEADS
SWA_KV_WIDTH = SWA_KV_HEADS * SWA_HEAD_DIM
WINDOW = 128
BLOCK = 128
REL_BUCKETS = 32
REL_MAX_DIST = 128
XA_HEADS = 4
XA_HEAD_DIM = D_MODEL // XA_HEADS
D_FF = 256 * ((8 * D_MODEL // 3 + 255) // 256)
FFN_CONV = 3
ALPHA = (2.0 * DEPTH) ** 0.25
BETA = (8.0 * DEPTH) ** -0.25
EPS = 1e-5
IN_SPLITS = (2 * ML_WIDTH, 3 * ML_WIDTH, 4 * ML_WIDTH, 4 * ML_WIDTH + ML_HEADS, 4 * ML_WIDTH + 2 * ML_HEADS, 4 * ML_WIDTH + 2 * ML_HEADS + SWA_WIDTH, 4 * ML_WIDTH + 2 * ML_HEADS + SWA_WIDTH + SWA_KV_WIDTH)
N_IN = IN_SPLITS[-1] + SWA_KV_WIDTH

kernel_name = "hybrid_mlstm_swa_deepnorm_block"

f32 = jnp.float32


def layer_norm(x, g, b):
    xf = x.astype(f32)
    mu = xf.mean(-1, keepdims=True)
    var = jnp.square(xf - mu).mean(-1, keepdims=True)
    return ((xf - mu) * lax.rsqrt(var + EPS) * g.astype(f32) + b.astype(f32)).astype(x.dtype)


def causal_dwconv(x, w, b):
    K = w.shape[0]
    S = x.shape[1]
    xp = jnp.pad(x, ((0, 0), (K - 1, 0), (0, 0)))
    y = b + xp[:, 0:S] * w[0]
    for j in range(1, K):
        y = y + xp[:, j:j + S] * w[j]
    return y


def t5_bucket(dist):
    n = jnp.maximum(dist, 0)
    max_exact = REL_BUCKETS // 2
    nf = jnp.maximum(n, 1).astype(f32)
    large = max_exact + (jnp.log(nf / max_exact) / math.log(REL_MAX_DIST / max_exact) * (REL_BUCKETS - max_exact)).astype(jnp.int32)
    large = jnp.minimum(large, REL_BUCKETS - 1)
    return jnp.where(n < max_exact, n, large)


def mlstm(q, k, v, o_pre, i_pre, f_pre, norm_g):
    B, S, _ = q.shape
    nc = S // ML_CHUNK
    L = ML_CHUNK

    def heads(t):
        return t.astype(f32).reshape(B, nc, L, ML_HEADS, ML_HEAD_DIM).transpose(1, 0, 3, 2, 4)

    def gates(t):
        return t.astype(f32).reshape(B, nc, L, ML_HEADS).transpose(1, 0, 3, 2)

    qc = heads(q)
    kc = heads(k) * (ML_HEAD_DIM ** -0.5)
    vc = heads(v)
    ic = gates(i_pre)
    lfc = jax.nn.log_sigmoid(gates(f_pre))
    causal = jnp.tril(jnp.ones((L, L), dtype=bool))

    def step(carry, inp):
        C, n, m = carry
        qb, kb, vb, ig, lf = inp
        b = jnp.cumsum(lf, axis=-1)
        Dm = jnp.where(causal, b[..., :, None] - b[..., None, :] + ig[..., None, :], -jnp.inf)
        inter = b + m[..., None]
        m_t = jnp.maximum(inter, Dm.max(-1))
        w_inter = jnp.exp(inter - m_t)
        s = jnp.einsum('bhtd,bhsd->bhts', qb, kb) * jnp.exp(Dm - m_t[..., None])
        num = w_inter[..., None] * jnp.einsum('bhtd,bhde->bhte', qb, C) + jnp.einsum('bhts,bhse->bhte', s, vb)
        den = w_inter * jnp.einsum('bhtd,bhd->bht', qb, n) + s.sum(-1)
        h = num / jnp.maximum(jnp.abs(den), jnp.exp(-m_t))[..., None]
        g = b[..., -1]
        a = g[..., None] - b + ig
        m_new = jnp.maximum(g + m, a.max(-1))
        decay = jnp.exp(g + m - m_new)
        wk = jnp.exp(a - m_new[..., None])
        C_new = decay[..., None, None] * C + jnp.einsum('bhsd,bhse->bhde', kb * wk[..., None], vb)
        n_new = decay[..., None] * n + jnp.einsum('bhs,bhsd->bhd', wk, kb)
        return (C_new, n_new, m_new), h

    init = (jnp.zeros((B, ML_HEADS, ML_HEAD_DIM, ML_HEAD_DIM), f32),
            jnp.zeros((B, ML_HEADS, ML_HEAD_DIM), f32),
            jnp.zeros((B, ML_HEADS), f32))
    _, h = lax.scan(step, init, (qc, kc, vc, ic, lfc))
    mu = h.mean(-1, keepdims=True)
    var = jnp.square(h - mu).mean(-1, keepdims=True)
    hn = ((h - mu) * lax.rsqrt(var + EPS)).transpose(1, 0, 3, 2, 4).reshape(B, S, ML_WIDTH)
    hn = hn * norm_g.astype(f32)
    return (jax.nn.sigmoid(o_pre.astype(f32)) * hn).astype(q.dtype)


def sliding_window_attention(q, k, v, sinks, rel_bias):
    B, S = q.shape[:2]
    nb = S // BLOCK
    qb = q.reshape(B, nb, BLOCK, SWA_KV_HEADS, SWA_GROUP, SWA_HEAD_DIM)

    def band(t):
        tb = t.reshape(B, nb, BLOCK, SWA_KV_HEADS, SWA_HEAD_DIM)
        prev = jnp.pad(tb, ((0, 0), (1, 0), (0, 0), (0, 0), (0, 0)))[:, :-1]
        return jnp.concatenate([prev, tb], axis=2)

    kb, vb = band(k), band(v)
    logits = jnp.einsum('bnqhgd,bnkhd->bnhgqk', qb, kb).astype(f32) * (SWA_HEAD_DIM ** -0.5)
    r = jnp.arange(BLOCK)[:, None]
    c = jnp.arange(2 * BLOCK)[None, :]
    dist = BLOCK + r - c
    bias = rel_bias.astype(f32)[t5_bucket(dist)]
    bias = bias.transpose(2, 0, 1).reshape(SWA_KV_HEADS, SWA_GROUP, BLOCK, 2 * BLOCK)
    kpos = jnp.arange(nb)[:, None, None] * BLOCK - BLOCK + c[None]
    valid = (dist >= 0) & (dist < WINDOW) & (kpos >= 0)
    logits = jnp.where(valid[None, :, None, None], logits + bias, -jnp.inf)
    sink = sinks.astype(f32).reshape(SWA_KV_HEADS, SWA_GROUP)[None, None, :, :, None, None]
    mx = jnp.maximum(logits.max(-1, keepdims=True), sink)
    p = jnp.exp(logits - mx)
    probs = (p / (p.sum(-1, keepdims=True) + jnp.exp(sink - mx))).astype(v.dtype)
    out = jnp.einsum('bnhgqk,bnkhd->bnqhgd', probs, vb)
    return out.reshape(B, S, SWA_WIDTH)


def hybrid_mixer(x, w_in, ml_conv_w, ml_conv_b, ml_i_bias, ml_f_bias, ml_norm_g, swa_sinks, rel_bias, w_out):
    B, S, _ = x.shape
    proj = x @ w_in
    ml_qk, ml_v, ml_o, ml_i, ml_f, sw_q, sw_k, sw_v = jnp.split(proj, IN_SPLITS, axis=-1)
    ml_qk = jax.nn.silu(causal_dwconv(ml_qk, ml_conv_w, ml_conv_b))
    ml_q, ml_k = jnp.split(ml_qk, 2, axis=-1)
    h_ml = mlstm(ml_q, ml_k, ml_v, ml_o, ml_i + ml_i_bias, ml_f + ml_f_bias, ml_norm_g)
    h_sw = sliding_window_attention(sw_q.reshape(B, S, SWA_HEADS, SWA_HEAD_DIM),
                                    sw_k.reshape(B, S, SWA_KV_HEADS, SWA_HEAD_DIM),
                                    sw_v.reshape(B, S, SWA_KV_HEADS, SWA_HEAD_DIM),
                                    swa_sinks, rel_bias)
    return jnp.concatenate([h_ml, h_sw], axis=-1) @ w_out


def memory_cross_attention(x, mem, wq, wkv, wo):
    B, S, _ = x.shape
    M = mem.shape[1]
    q = (x @ wq).reshape(B, S, XA_HEADS, XA_HEAD_DIM)
    k, v = jnp.split(mem @ wkv, 2, axis=-1)
    k = k.reshape(B, M, XA_HEADS, XA_HEAD_DIM)
    v = v.reshape(B, M, XA_HEADS, XA_HEAD_DIM)
    logits = jnp.einsum('bshd,bmhd->bhsm', q, k).astype(f32) * (XA_HEAD_DIM ** -0.5)
    p = jax.nn.softmax(logits, axis=-1).astype(x.dtype)
    o = jnp.einsum('bhsm,bmhd->bshd', p, v).reshape(B, S, D_MODEL)
    return o @ wo


def conv_ffn(x, w_up, conv_w, conv_b, w_down):
    u = causal_dwconv(x @ w_up, conv_w, conv_b)
    g, val = jnp.split(u, 2, axis=-1)
    return (jax.nn.gelu(g) * val) @ w_down


def setup_inputs(seed: int = 0) -> dict:
    key = jax.random.key(seed)
    ks = jax.random.split(key, 24)
    nrm = lambda k, shape, s: jax.random.normal(k, shape, f32) * s
    L = DEPTH
    return {
        'x': nrm(ks[0], (BATCH, SEQ, D_MODEL), 1.0),
        'mem': nrm(ks[1], (BATCH, N_MEM, D_MODEL), 1.0),
        'rel_bias': nrm(ks[2], (REL_BUCKETS, SWA_HEADS), 0.5),
        'w_in': nrm(ks[3], (L, D_MODEL, N_IN), D_MODEL ** -0.5),
        'ml_conv_w': nrm(ks[4], (L, ML_CONV, 2 * ML_WIDTH), ML_CONV ** -0.5),
        'ml_conv_b': nrm(ks[5], (L, 2 * ML_WIDTH), 0.02),
        'ml_i_bias': nrm(ks[6], (L, ML_HEADS), 0.1),
        'ml_f_bias': jnp.linspace(3.0, 6.0, ML_HEADS, dtype=f32)[None, :] + nrm(ks[7], (L, ML_HEADS), 0.1),
        'ml_norm_g': 1.0 + nrm(ks[8], (L, ML_WIDTH), 0.05),
        'swa_sinks': nrm(ks[9], (L, SWA_HEADS), 0.5),
        'w_out': nrm(ks[10], (L, MIX_WIDTH, D_MODEL), BETA * MIX_WIDTH ** -0.5),
        'ln1_g': 1.0 + nrm(ks[11], (L, D_MODEL), 0.05),
        'ln1_b': nrm(ks[12], (L, D_MODEL), 0.02),
        'xa_wq': nrm(ks[13], (L, D_MODEL, D_MODEL), D_MODEL ** -0.5),
        'xa_wkv': nrm(ks[14], (L, D_MODEL, 2 * D_MODEL), D_MODEL ** -0.5),
        'xa_wo': nrm(ks[15], (L, D_MODEL, D_MODEL), BETA * D_MODEL ** -0.5),
        'ln2_g': 1.0 + nrm(ks[16], (L, D_MODEL), 0.05),
        'ln2_b': nrm(ks[17], (L, D_MODEL), 0.02),
        'ffn_w_up': nrm(ks[18], (L, D_MODEL, 2 * D_FF), D_MODEL ** -0.5),
        'ffn_conv_w': nrm(ks[19], (L, FFN_CONV, 2 * D_FF), FFN_CONV ** -0.5),
        'ffn_conv_b': nrm(ks[20], (L, 2 * D_FF), 0.02),
        'ffn_w_down': nrm(ks[21], (L, D_FF, D_MODEL), BETA * D_FF ** -0.5),
        'ln3_g': 1.0 + nrm(ks[22], (L, D_MODEL), 0.05),
        'ln3_b': nrm(ks[23], (L, D_MODEL), 0.02),
    }


def reference(x, mem, rel_bias, w_in, ml_conv_w, ml_conv_b, ml_i_bias, ml_f_bias, ml_norm_g, swa_sinks, w_out, ln1_g, ln1_b, xa_wq, xa_wkv, xa_wo, ln2_g, ln2_b, ffn_w_up, ffn_conv_w, ffn_conv_b, ffn_w_down, ln3_g, ln3_b):
    for l in range(DEPTH):
        h = hybrid_mixer(x, w_in[l], ml_conv_w[l], ml_conv_b[l], ml_i_bias[l], ml_f_bias[l], ml_norm_g[l], swa_sinks[l], rel_bias, w_out[l])
        x = layer_norm(ALPHA * x + h, ln1_g[l], ln1_b[l])
        h = memory_cross_attention(x, mem, xa_wq[l], xa_wkv[l], xa_wo[l])
        x = layer_norm(ALPHA * x + h, ln2_g[l], ln2_b[l])
        h = conv_ffn(x, ffn_w_up[l], ffn_conv_w[l], ffn_conv_b[l], ffn_w_down[l])
        x = layer_norm(ALPHA * x + h, ln3_g[l], ln3_b[l])
    return x
```

```cpp
#include <hip/hip_runtime.h>
#include <cstdio>
#include <cstdint>

constexpr int DM = 1024, BATCH = 8, SEQ = 4096, M = BATCH * SEQ, DEPTH = 2;
constexpr int NMEM = 256, MLW = 512, MLH = 4, MLD = 128;
constexpr int SWH = 8, SWD = 64, SWKV = 2;
constexpr int NIN = 2824, NPROJ = 2816;
constexpr int DFF = 2816, DFF2 = 5632;
constexpr float ALPHA = 1.41421356237f, EPS = 1e-5f;
constexpr int PC_Q = 0, PC_K = 512, PC_V = 1024, PC_O = 1536, PC_SQ = 2048, PC_SK = 2560, PC_SV = 2688;

typedef _Float16 f16;
typedef _Float16 f16x8 __attribute__((ext_vector_type(8)));
typedef _Float16 f16x4 __attribute__((ext_vector_type(4)));
typedef _Float16 f16x2 __attribute__((ext_vector_type(2)));
typedef float f32x2 __attribute__((ext_vector_type(2)));
typedef float f32x4 __attribute__((ext_vector_type(4)));
typedef float f32x16 __attribute__((ext_vector_type(16)));
typedef unsigned u32x4 __attribute__((ext_vector_type(4)));
typedef unsigned u32x2 __attribute__((ext_vector_type(2)));

#define GAS __attribute__((address_space(1)))
#define LAS __attribute__((address_space(3)))
typedef GAS unsigned gu32;
#define RLX_AGENT __ATOMIC_RELAXED, __HIP_MEMORY_SCOPE_AGENT
#define LDS_WAIT() asm volatile("s_waitcnt lgkmcnt(0)" ::: "memory")
#define VM_WAIT() asm volatile("s_waitcnt vmcnt(0)" ::: "memory")

constexpr size_t MiB = 1u << 20;
constexpr size_t WS_CTL = 0, CTL_ZERO_BYTES = 1 * MiB;
constexpr size_t WL_WIN = 0;
constexpr size_t WL_WG = WL_WIN + (size_t)NPROJ * DM * 2;
constexpr size_t WL_WOUT = WL_WG + 8 * DM * 4;
constexpr size_t WL_WQN = WL_WOUT + (size_t)DM * DM * 2;
constexpr size_t WL_WKV = WL_WQN + (size_t)DM * DM * 2;
constexpr size_t WL_WO = WL_WKV + (size_t)2 * DM * DM * 2;
constexpr size_t WL_WUP = WL_WO + (size_t)DM * DM * 2;
constexpr size_t WL_WDN = WL_WUP + (size_t)DFF2 * DM * 2;
constexpr size_t WL_KV = WL_WDN + (size_t)DM * DFF * 2;
constexpr size_t WL_GT = WL_KV + (size_t)2048 * 2048 * 2;
constexpr size_t WL_VWT = WL_GT + (size_t)8 * DM * DM * 2;
constexpr size_t WL_SIZE = WL_VWT + (size_t)8 * DM * DM * 2;
static_assert(WL_SIZE % 256 == 0, "align");
constexpr size_t WS_W = 1 * MiB;
constexpr size_t WS_MEMB = WS_W + 2 * WL_SIZE;
constexpr size_t WS_GATES = WS_MEMB + (size_t)2048 * DM * 2;
constexpr size_t WS_XB = WS_GATES + (size_t)M * 8 * 4;
constexpr size_t WS_BIG = WS_XB + (size_t)M * DM * 2;
constexpr size_t WS_HMIX = WS_BIG + (size_t)M * NPROJ * 2;
constexpr size_t WS_END = WS_HMIX + (size_t)M * DM * 2;
static_assert(WS_END <= 512 * MiB, "ws");
constexpr int CW_TMO = 0, CW_CODE = 1, CW_BAR = 4096;

#define XB_TMO      128
#define XB_XCNT(j)  (256  + 64 * (j))
#define XB_XSUB(j)  (1280 + 64 * (j))
#define XB_XGEN(j)  (2304 + 64 * (j))
#define XB_TOP      3328
#define XB_TOPGEN   3392
#define XCD_BAR_WORDS 3456
#define XB_SPIN_CAP (1u << 20)
__device__ __forceinline__ unsigned xb_ld(unsigned* p)              { return __hip_atomic_load(p, __ATOMIC_RELAXED, __HIP_MEMORY_SCOPE_AGENT); }
__device__ __forceinline__ unsigned xb_add(unsigned* p, unsigned v) { return __hip_atomic_fetch_add(p, v, __ATOMIC_RELAXED, __HIP_MEMORY_SCOPE_AGENT); }
__device__ __forceinline__ unsigned xb_xcc_id() { return (unsigned)__builtin_amdgcn_s_getreg((3 << 11) | 20) & 0xFu; }
#define XB_SPIN(cond, bar) do { unsigned _sp = 0; while (cond) { __builtin_amdgcn_s_sleep(1); \
    if ((++_sp & 255u) == 0u) { if (xb_ld(&(bar)[XB_TMO])) break; if (_sp > XB_SPIN_CAP) { atomicAdd(&(bar)[XB_TMO], 1u); break; } } } } while (0)
struct XcdBarrier { unsigned* bar; unsigned x; volatile LAS unsigned* st; };
__device__ __forceinline__ XcdBarrier xcd_barrier_post(unsigned* bar, volatile LAS unsigned* st) {
    XcdBarrier b; b.bar = bar; b.x = xb_xcc_id(); b.st = st;
    if (threadIdx.x == 0) (void)xb_add(&bar[XB_XCNT(b.x)], 1u);
    return b;
}
__device__ __forceinline__ void xcd_barrier_complete(unsigned* bar, unsigned x, unsigned& nloc, unsigned& nx) {
    const unsigned G = gridDim.x * gridDim.y * gridDim.z;
    unsigned sum, cnt, mine, sp = 0u;
    for (;;) {
        sum = 0u; cnt = 0u; mine = 0u;
#pragma unroll
        for (unsigned j = 0; j < 16; ++j) { const unsigned c = xb_ld(&bar[XB_XCNT(j)]); sum += c; cnt += (c > 0u) ? 1u : 0u; mine = (j == x) ? c : mine; }
        if (sum == G) break;
        __builtin_amdgcn_s_sleep(1);
        if ((++sp & 255u) == 0u) { if (xb_ld(&bar[XB_TMO])) break; if (sp > XB_SPIN_CAP) { atomicAdd(&bar[XB_TMO], 1u); break; } }
    }
    nloc = mine > 0u ? mine : 1u; nx = cnt > 0u ? cnt : 1u;
}
__device__ __forceinline__ void xcd_barrier(const XcdBarrier& b) {
    asm volatile("s_waitcnt vmcnt(0)" ::: "memory");
    __syncthreads();
    if (threadIdx.x == 0) {
        unsigned* bar = b.bar;
        __builtin_amdgcn_s_waitcnt(0);
        unsigned nloc = b.st[0], nx = b.st[1];
        if (nloc == 0u) { xcd_barrier_complete(bar, b.x, nloc, nx); b.st[0] = nloc; b.st[1] = nx; }
        const unsigned old = xb_add(&bar[XB_XSUB(b.x)], 1u);
        const unsigned gen = old / nloc;
        if (old + 1u == (gen + 1u) * nloc) {
            __builtin_amdgcn_fence(__ATOMIC_RELEASE, "agent");
            asm volatile("s_waitcnt vmcnt(0)" ::: "memory");
            const unsigned og = xb_add(&bar[XB_TOP], 1u);
            const unsigned tg = og / nx;
            if (og + 1u == (tg + 1u) * nx) xb_add(&bar[XB_TOPGEN], 1u);
            else XB_SPIN(xb_ld(&bar[XB_TOPGEN]) == tg, bar);
            __builtin_amdgcn_fence(__ATOMIC_ACQUIRE, "agent");
            xb_add(&bar[XB_XGEN(b.x)], 1u);
            asm volatile("s_waitcnt vmcnt(0)" ::: "memory");
        } else {
            XB_SPIN(xb_ld(&bar[XB_XGEN(b.x)]) == gen, bar);
            __builtin_amdgcn_fence(__ATOMIC_ACQUIRE, "agent");
            asm volatile("s_waitcnt vmcnt(0)" ::: "memory");
        }
    }
    __syncthreads();
}

constexpr int NWAVES = 8, NTHR = 512;
constexpr int RING_BYTES = 131072, LDSCTL_OFF = RING_BYTES, MISC_OFF = LDSCTL_OFF + 320, LDS_BYTES = 147456;
struct LayerW {
    const float *w_in, *ml_conv_w, *ml_conv_b, *ml_i_bias, *ml_f_bias, *ml_norm_g, *swa_sinks, *w_out, *ln1_g, *ln1_b, *xa_wq, *xa_wkv, *xa_wo, *ln2_g, *ln2_b,
                *w_up, *ffn_conv_w, *ffn_conv_b, *w_down, *ln3_g, *ln3_b;
    unsigned char* wb;
};
struct Frame {
    LAS unsigned char* lds;
    volatile LAS unsigned* MISC;
    gu32* ctl;
    int tid, lane, wave, vcu, G, gw, ngw;
    const float *x_in, *mem, *rel_bias; float* out; unsigned char* ws;
};
__device__ __forceinline__ float wave_sum(float v) {
#pragma unroll
    for (int o = 1; o < 64; o <<= 1) v += __shfl_xor(v, o);
    return v;
}
__device__ __forceinline__ float wave_max(float v) {
#pragma unroll
    for (int o = 1; o < 64; o <<= 1) v = fmaxf(v, __shfl_xor(v, o));
    return v;
}
__device__ __forceinline__ unsigned pk2h(float lo, float hi) { f32x2 v = {lo, hi}; f16x2 h = __builtin_convertvector(v, f16x2); return __builtin_bit_cast(unsigned, h); }
__device__ __forceinline__ float siluf(float x) { return x / (1.f + __expf(-x)); }
__device__ __forceinline__ float sigmoidf_(float x) { return 1.f / (1.f + __expf(-x)); }
__device__ __forceinline__ float gelu_tanh(float x) { const float z = 1.5957691216057308f * (x + 0.044715f * x * x * x); return x / (1.f + __expf(-z)); }
__device__ __forceinline__ float logsigmoidf_(float x) { return fminf(x, 0.f) - log1pf(__expf(-fabsf(x))); }

__device__ __forceinline__ LayerW layer_w(void* const* in, unsigned char* ws, int l) {
    LayerW L;
    L.w_in = (const float*)in[3] + (size_t)l * DM * NIN;       L.ml_conv_w = (const float*)in[4] + (size_t)l * 4 * 1024; L.ml_conv_b = (const float*)in[5] + (size_t)l * 1024;
    L.ml_i_bias = (const float*)in[6] + l * 4;                  L.ml_f_bias = (const float*)in[7] + l * 4;                L.ml_norm_g = (const float*)in[8] + l * 512;
    L.swa_sinks = (const float*)in[9] + l * 8;                  L.w_out = (const float*)in[10] + (size_t)l * DM * DM;     L.ln1_g = (const float*)in[11] + l * DM; L.ln1_b = (const float*)in[12] + l * DM;
    L.xa_wq = (const float*)in[13] + (size_t)l * DM * DM;       L.xa_wkv = (const float*)in[14] + (size_t)l * DM * 2 * DM; L.xa_wo = (const float*)in[15] + (size_t)l * DM * DM;
    L.ln2_g = (const float*)in[16] + l * DM;                    L.ln2_b = (const float*)in[17] + l * DM;
    L.w_up = (const float*)in[18] + (size_t)l * DM * DFF2;      L.ffn_conv_w = (const float*)in[19] + (size_t)l * 3 * DFF2; L.ffn_conv_b = (const float*)in[20] + (size_t)l * DFF2;
    L.w_down = (const float*)in[21] + (size_t)l * DFF * DM;     L.ln3_g = (const float*)in[22] + l * DM;                  L.ln3_b = (const float*)in[23] + l * DM;
    L.wb = ws + WS_W + (size_t)l * WL_SIZE;
    return L;
}

__device__ __forceinline__ void transpose_item(const float* W, int ldw, int K, f16* WT, int ns, int nd, int k0, LAS float* scr, int lane) {
#pragma unroll 8
    for (int i = 0; i < 32; ++i) { const int kk = 2 * i + (lane >> 5); scr[kk * 33 + (lane & 31)] = W[(size_t)(k0 + kk) * ldw + ns + (lane & 31)]; }
    LDS_WAIT(); asm volatile("" ::: "memory");
    const int c = lane & 7;
#pragma unroll
    for (int j = 0; j < 4; ++j) { const int n = (lane >> 3) + 8 * j; const LAS float* s = scr + (8 * c) * 33 + n;
        u32x4 o; o.x = pk2h(s[0 * 33], s[1 * 33]); o.y = pk2h(s[2 * 33], s[3 * 33]); o.z = pk2h(s[4 * 33], s[5 * 33]); o.w = pk2h(s[6 * 33], s[7 * 33]);
        *(u32x4*)(WT + (size_t)(nd + n) * K + k0 + 8 * c) = o; }
    LDS_WAIT(); asm volatile("" ::: "memory");
}
template <class Map>
__device__ __forceinline__ void transpose_all(Frame& F, const float* W, int ldw, int K, f16* WT, int ND, Map smap) {
    LAS float* scr = (LAS float*)(F.lds + F.wave * 16384);
    const int ng = ND / 32, nk = K / 64;
    for (int it = F.gw; it < ng * nk; it += F.ngw) { const int g = it % ng, kb = it / ng; transpose_item(W, ldw, K, WT, smap(g * 32), g * 32, kb * 64, scr, F.lane); }
}
__device__ __forceinline__ void convert_f16(Frame& F, const float* src, f16* dst, size_t n) {
    const size_t nv = n / 8;
    for (size_t i = (size_t)F.gw * 64 + F.lane; i < nv; i += (size_t)F.ngw * 64) {
        const f32x4 a = ((const f32x4*)src)[2 * i], b = ((const f32x4*)src)[2 * i + 1];
        u32x4 o; o.x = pk2h(a.x, a.y); o.y = pk2h(a.z, a.w); o.z = pk2h(b.x, b.y); o.w = pk2h(b.z, b.w);
        ((u32x4*)dst)[i] = o;
    }
}

struct NG { const f16* A; long lda; const f16* Bt; long ldb; int Mb, N, K; int nb0, nb1; long sa0, sa1, sb0, sb1, so0, so1; };
template <class Epi>
__device__ __forceinline__ void ngemm(Frame& F, const NG g, const Epi& E) {
    const int tm = g.Mb / 64, tn = g.N / 64, per = tm * tn, total = per * g.nb0 * g.nb1;
    const int r32 = F.lane & 31, hi = F.lane >> 5;
    for (int t = F.gw; t < total; t += F.ngw) {
        const int z = t / per, tt = t % per, pm = tt / tn, pn = tt % tn, z0 = z / g.nb1, z1 = z % g.nb1;
        const f16* Ab = g.A + z0 * g.sa0 + z1 * g.sa1 + (long)(pm * 64 + r32) * g.lda + hi * 8;
        const f16* Bb = g.Bt + z0 * g.sb0 + z1 * g.sb1 + (long)(pn * 64 + r32) * g.ldb + hi * 8;
        f32x16 acc[2][2];
#pragma unroll
        for (int i = 0; i < 2; ++i)
#pragma unroll
            for (int j = 0; j < 2; ++j)
#pragma unroll
                for (int r = 0; r < 16; ++r) acc[i][j][r] = 0.f;
        for (int k = 0; k < g.K; k += 16) {
            const f16x8 a0 = *(const f16x8*)(Ab + k), a1 = *(const f16x8*)(Ab + 32 * g.lda + k);
            const f16x8 b0 = *(const f16x8*)(Bb + k), b1 = *(const f16x8*)(Bb + 32 * g.ldb + k);
            acc[0][0] = __builtin_amdgcn_mfma_f32_32x32x16_f16(b0, a0, acc[0][0], 0, 0, 0);
            acc[0][1] = __builtin_amdgcn_mfma_f32_32x32x16_f16(b1, a0, acc[0][1], 0, 0, 0);
            acc[1][0] = __builtin_amdgcn_mfma_f32_32x32x16_f16(b0, a1, acc[1][0], 0, 0, 0);
            acc[1][1] = __builtin_amdgcn_mfma_f32_32x32x16_f16(b1, a1, acc[1][1], 0, 0, 0);
        }
        const long ooff = z0 * g.so0 + z1 * g.so1;
#pragma unroll
        for (int i = 0; i < 2; ++i)
#pragma unroll
            for (int j = 0; j < 2; ++j)
#pragma unroll
                for (int q = 0; q < 4; ++q) {
                    const f32x4 v = {acc[i][j][4 * q], acc[i][j][4 * q + 1], acc[i][j][4 * q + 2], acc[i][j][4 * q + 3]};
                    E(ooff, pm * 64 + 32 * i + r32, pn * 64 + 32 * j + 8 * q + 4 * hi, v);
                }
    }
}
struct EpF16 { f16* O; long ldo; float scale;
    __device__ __forceinline__ void operator()(long ooff, int row, int col, f32x4 v) const { u32x2 w; w.x = pk2h(v.x * scale, v.y * scale); w.y = pk2h(v.z * scale, v.w * scale); *(u32x2*)(O + ooff + (long)row * ldo + col) = w; } };
struct EpF32 { float* O; long ldo;
    __device__ __forceinline__ void operator()(long ooff, int row, int col, f32x4 v) const { *(f32x4*)(O + ooff + (long)row * ldo + col) = v; } };
struct EpRes { const float* X; float* O; long ldo;
    __device__ __forceinline__ void operator()(long ooff, int row, int col, f32x4 v) const { const f32x4 x = *(const f32x4*)(X + ooff + (long)row * ldo + col); *(f32x4*)(O + ooff + (long)row * ldo + col) = x * ALPHA + v; } };

__device__ __forceinline__ void n_ln(Frame& F, float* X, const float* g, const float* b, f16* XB) {
    for (int m = F.gw; m < M; m += F.ngw) {
        f32x4* xr = (f32x4*)(X + (size_t)m * DM) + F.lane;
        f32x4 v[4]; float s = 0.f;
#pragma unroll
        for (int j = 0; j < 4; ++j) { v[j] = xr[64 * j]; s += (v[j].x + v[j].y) + (v[j].z + v[j].w); }
        const float mean = wave_sum(s) * (1.f / DM); float s2 = 0.f;
#pragma unroll
        for (int j = 0; j < 4; ++j) { v[j] = v[j] - mean; s2 += (v[j].x * v[j].x + v[j].y * v[j].y) + (v[j].z * v[j].z + v[j].w * v[j].w); }
        const float rstd = 1.f / sqrtf(wave_sum(s2) * (1.f / DM) + EPS);
        u32x2* o8 = (u32x2*)(XB + (size_t)m * DM) + F.lane;
#pragma unroll
        for (int j = 0; j < 4; ++j) { const f32x4 gg = ((const f32x4*)g)[F.lane + 64 * j], bb = ((const f32x4*)b)[F.lane + 64 * j];
            const f32x4 o = v[j] * rstd * gg + bb; xr[64 * j] = o; u32x2 w; w.x = pk2h(o.x, o.y); w.y = pk2h(o.z, o.w); o8[64 * j] = w; }
    }
}
__device__ __forceinline__ void n_gates(Frame& F, const f16* XB, const float* Wg, const float* ib, const float* fb, float* gates) {
    for (int m = F.gw; m < M; m += F.ngw) {
        float xs[16];
#pragma unroll
        for (int j = 0; j < 2; ++j) { const f16x8 xv = *(const f16x8*)(XB + (size_t)m * DM + j * 512 + F.lane * 8);
#pragma unroll
            for (int e = 0; e < 8; ++e) xs[j * 8 + e] = (float)xv[e]; }
        float acc[8];
#pragma unroll
        for (int c = 0; c < 8; ++c) { float a = 0.f;
#pragma unroll
            for (int j = 0; j < 2; ++j)
#pragma unroll
                for (int e = 0; e < 8; ++e) a += xs[j * 8 + e] * Wg[c * DM + j * 512 + F.lane * 8 + e];
            acc[c] = wave_sum(a); }
        if (F.lane < 8) { float v = 0.f;
#pragma unroll
            for (int c = 0; c < 8; ++c) if (F.lane == c) v = acc[c];
            v += (F.lane < 4) ? ib[F.lane] : fb[F.lane - 4]; gates[(size_t)m * 8 + F.lane] = v; }
    }
}
__device__ __forceinline__ void n_mlstm(Frame& F, const LayerW& L, const f16* proj, const float* gates, f16* hmix) {
    LAS float* sq = (LAS float*)F.lds; LAS float* sk = sq + 128; LAS float* sv = sk + 128; LAS float* part = sv + 128; LAS float* red = part + 512;
    const int tid = F.tid, e = tid & 127, dq = tid >> 7;
    for (int bh = F.vcu; bh < BATCH * MLH; bh += F.G) {
        const int b = bh / MLH, h = bh % MLH;
        float c[32]; float nn = 0.f, mst = 0.f;
#pragma unroll
        for (int i = 0; i < 32; ++i) c[i] = 0.f;
        float cw[4], cb = 0.f; int ccol = 0;
        if (tid < 256) { const int which = tid >> 7, d = tid & 127; ccol = which * 512 + h * 128 + d; cb = L.ml_conv_b[ccol];
#pragma unroll
            for (int j = 0; j < 4; ++j) cw[j] = L.ml_conv_w[j * 1024 + ccol]; }
        const float ng = (tid < 128) ? L.ml_norm_g[h * 128 + e] : 0.f;
        for (int t = 0; t < SEQ; ++t) {
            const size_t row = (size_t)b * SEQ + t;
            if (tid < 256) { float a = cb;
#pragma unroll
                for (int j = 0; j < 4; ++j) { const int tt = t - 3 + j; if (tt >= 0) a += cw[j] * (float)proj[(row - 3 + j) * NPROJ + ccol]; }
                a = siluf(a); if (tid >= 128) { a *= 0.08838834764831845f; sk[tid & 127] = a; } else sq[tid] = a;
            } else if (tid < 384) { sv[tid - 256] = (float)proj[row * NPROJ + PC_V + h * 128 + (tid - 256)]; }
            const float ig = gates[row * 8 + h], lf = logsigmoidf_(gates[row * 8 + 4 + h]);
            const float mnew = fmaxf(lf + mst, ig), fg = __expf(lf + mst - mnew), ii = __expf(ig - mnew); mst = mnew;
            __syncthreads();
            const float ve = sv[e] * ii; float p = 0.f;
#pragma unroll
            for (int i = 0; i < 32; ++i) { const int d = 32 * dq + i; c[i] = fg * c[i] + sk[d] * ve; p += sq[d] * c[i]; }
            part[dq * 128 + e] = p;
            if (tid < 128) { nn = fg * nn + ii * sk[tid]; const float dp = wave_sum(sq[tid] * nn); if (F.lane == 0) red[F.wave] = dp; }
            __syncthreads();
            float hv = 0.f;
            if (tid < 128) { const float num = (part[e] + part[128 + e]) + (part[256 + e] + part[384 + e]); const float den = red[0] + red[1];
                hv = num / fmaxf(fabsf(den), __expf(-mst)); const float s1 = wave_sum(hv); if (F.lane == 0) red[4 + F.wave] = s1; }
            __syncthreads();
            float dv = 0.f;
            if (tid < 128) { const float mu = (red[4] + red[5]) * (1.f / 128.f); dv = hv - mu; const float s2 = wave_sum(dv * dv); if (F.lane == 0) red[8 + F.wave] = s2; }
            __syncthreads();
            if (tid < 128) { const float var = (red[8] + red[9]) * (1.f / 128.f); const float hn = dv * rsqrtf(var + EPS) * ng;
                const float og = sigmoidf_((float)proj[row * NPROJ + PC_O + h * 128 + e]); hmix[row * DM + h * 128 + e] = (f16)(og * hn); }
        }
        __syncthreads();
    }
}
__device__ __forceinline__ int t5_bucket(int d) { if (d < 16) return d; const int v = 16 + (int)(logf((float)d * (1.f / 16.f)) / 2.0794415416798357f * 16.f); return v < 31 ? v : 31; }
__device__ __forceinline__ void n_swa(Frame& F, const LayerW& L, const float* rel_bias, const f16* proj, f16* hmix) {
    const size_t nthr = (size_t)F.G * NTHR;
    for (size_t it = (size_t)F.vcu * NTHR + F.tid; it < (size_t)M * SWH; it += nthr) {
        const int hq = (int)(it / M); const size_t row = it % M; const int t = (int)(row % SEQ), kvh = hq >> 2;
        float q[64], o[64];
#pragma unroll
        for (int d8 = 0; d8 < 8; ++d8) { const f16x8 v = *(const f16x8*)(proj + row * NPROJ + PC_SQ + hq * 64 + d8 * 8);
#pragma unroll
            for (int e = 0; e < 8; ++e) { q[d8 * 8 + e] = (float)v[e] * 0.125f; o[d8 * 8 + e] = 0.f; } }
        float mx = L.swa_sinks[hq], l = 1.f;
        const int blk0 = (t / 128) * 128 - 128;
        int klo = t - 127; if (klo < blk0) klo = blk0; if (klo < 0) klo = 0;
        for (int kp = klo; kp <= t; ++kp) {
            const size_t krow = row - (size_t)(t - kp);
            float s = 0.f;
#pragma unroll
            for (int d8 = 0; d8 < 8; ++d8) { const f16x8 v = *(const f16x8*)(proj + krow * NPROJ + PC_SK + kvh * 64 + d8 * 8);
#pragma unroll
                for (int e = 0; e < 8; ++e) s += q[d8 * 8 + e] * (float)v[e]; }
            s += rel_bias[t5_bucket(t - kp) * SWH + hq];
            const float mn = fmaxf(mx, s), al = __expf(mx - mn), p = __expf(s - mn); mx = mn; l = l * al + p;
#pragma unroll
            for (int d8 = 0; d8 < 8; ++d8) { const f16x8 v = *(const f16x8*)(proj + krow * NPROJ + PC_SV + kvh * 64 + d8 * 8);
#pragma unroll
                for (int e = 0; e < 8; ++e) o[d8 * 8 + e] = o[d8 * 8 + e] * al + p * (float)v[e]; }
        }
        const float rl = 1.f / l;
#pragma unroll
        for (int d8 = 0; d8 < 8; ++d8) { u32x4 w; w.x = pk2h(o[d8 * 8] * rl, o[d8 * 8 + 1] * rl); w.y = pk2h(o[d8 * 8 + 2] * rl, o[d8 * 8 + 3] * rl); w.z = pk2h(o[d8 * 8 + 4] * rl, o[d8 * 8 + 5] * rl); w.w = pk2h(o[d8 * 8 + 6] * rl, o[d8 * 8 + 7] * rl);
            *(u32x4*)(hmix + row * DM + MLW + hq * 64 + d8 * 8) = w; }
    }
}
__device__ __forceinline__ void n_softmax(Frame& F, const float* S, f16* P) {
    for (size_t it = F.gw; it < (size_t)M * 4; it += F.ngw) {
        const f32x4 v = *(const f32x4*)(S + it * 256 + F.lane * 4);
        const float mx = wave_max(fmaxf(fmaxf(v.x, v.y), fmaxf(v.z, v.w)));
        const float e0 = __expf(v.x - mx), e1 = __expf(v.y - mx), e2 = __expf(v.z - mx), e3 = __expf(v.w - mx);
        const float r = 1.f / wave_sum((e0 + e1) + (e2 + e3));
        u32x2 w; w.x = pk2h(e0 * r, e1 * r); w.y = pk2h(e2 * r, e3 * r); *(u32x2*)(P + it * 256 + F.lane * 4) = w;
    }
}
__device__ __forceinline__ void n_convgelu(Frame& F, const LayerW& L, const f16* U, int r0, int nr, f16* H) {
    const size_t nthr = (size_t)F.G * NTHR, tot = (size_t)nr * DFF;
    for (size_t it = (size_t)F.vcu * NTHR + F.tid; it < tot; it += nthr) {
        const int lr = (int)(it / DFF), j = (int)(it % DFF); const int t = (r0 + lr) % SEQ;
        float g = L.ffn_conv_b[j], v = L.ffn_conv_b[DFF + j];
#pragma unroll
        for (int k = 0; k < 3; ++k) { const int tt = t - 2 + k; if (tt >= 0) { g += L.ffn_conv_w[k * DFF2 + j] * (float)U[(size_t)(lr - 2 + k) * DFF2 + j]; v += L.ffn_conv_w[k * DFF2 + DFF + j] * (float)U[(size_t)(lr - 2 + k) * DFF2 + DFF + j]; } }
        H[(size_t)(r0 + lr) * DFF + j] = (f16)(gelu_tanh(g) * v);
    }
}

struct Args { void* in[24]; float* out; unsigned char* ws; int ph_lo, ph_hi; };
__global__ void __launch_bounds__(NTHR, 2) fwd_kernel(Args args) {
    extern __shared__ __attribute__((aligned(16))) unsigned char lds[];
    Frame F;
    F.lds = (LAS unsigned char*)lds; F.MISC = (volatile LAS unsigned*)(F.lds + MISC_OFF);
    F.tid = threadIdx.x; F.lane = F.tid & 63; F.wave = __builtin_amdgcn_readfirstlane(F.tid >> 6);
    F.G = gridDim.x; { const int bx = blockIdx.x; F.vcu = (F.G % 8 == 0) ? (bx % 8) * (F.G / 8) + bx / 8 : bx; }
    F.gw = F.vcu * NWAVES + F.wave; F.ngw = F.G * NWAVES;
    F.ws = args.ws; F.ctl = (gu32*)(args.ws + WS_CTL); F.out = args.out;
    F.x_in = (const float*)args.in[0]; F.mem = (const float*)args.in[1]; F.rel_bias = (const float*)args.in[2];
    for (int u = F.tid; u < (LDS_BYTES - LDSCTL_OFF) / 4; u += NTHR) ((LAS unsigned*)(F.lds + LDSCTL_OFF))[u] = 0u;
    __syncthreads();
    const bool single = (args.ph_hi - args.ph_lo) > 1;
    XcdBarrier bar; bar.bar = (unsigned*)(F.ctl + CW_BAR); bar.x = 0; bar.st = nullptr;
    if (single) bar = xcd_barrier_post((unsigned*)(F.ctl + CW_BAR), F.MISC + 8);
    int ph = 0;
    const int lo = args.ph_lo, hi = args.ph_hi;
#define PHASE_BEGIN if (lo <= ph && ph < hi) {
#define PHASE_END   if (ph + 1 < hi) xcd_barrier(bar); } ++ph;

    f16* memb = (f16*)(F.ws + WS_MEMB); float* gates = (float*)(F.ws + WS_GATES); f16* xb = (f16*)(F.ws + WS_XB);
    f16* proj = (f16*)(F.ws + WS_BIG); float* Sf = (float*)(F.ws + WS_BIG); f16* hffn = (f16*)(F.ws + WS_BIG);
    f16* hmix = (f16*)(F.ws + WS_HMIX); f16* Pb = (f16*)(F.ws + WS_HMIX); f16* uchunk = (f16*)(F.ws + WS_HMIX);

    PHASE_BEGIN
        for (int l = 0; l < DEPTH; ++l) {
            const LayerW L = layer_w(args.in, F.ws, l);
            transpose_all(F, L.w_in, NIN, DM, (f16*)(L.wb + WL_WIN), NPROJ, [](int n) { return n < 2048 ? n : n + 8; });
            transpose_all(F, L.w_out, DM, DM, (f16*)(L.wb + WL_WOUT), DM, [](int n) { return n; });
            transpose_all(F, L.xa_wkv, 2 * DM, DM, (f16*)(L.wb + WL_WKV), 2 * DM, [](int n) { return n; });
            transpose_all(F, L.xa_wo, DM, DM, (f16*)(L.wb + WL_WO), DM, [](int n) { return n; });
            transpose_all(F, L.w_up, DFF2, DM, (f16*)(L.wb + WL_WUP), DFF2, [](int n) { return n; });
            transpose_all(F, L.w_down, DM, DFF, (f16*)(L.wb + WL_WDN), DM, [](int n) { return n; });
            convert_f16(F, L.xa_wq, (f16*)(L.wb + WL_WQN), (size_t)DM * DM);
            float* Wg = (float*)(L.wb + WL_WG);
            for (int i = F.vcu * NTHR + F.tid; i < 8 * DM; i += F.G * NTHR) { const int c = i / DM, k = i % DM; Wg[i] = L.w_in[(size_t)k * NIN + 2048 + c]; }
        }
        convert_f16(F, F.mem, memb, (size_t)2048 * DM);
        convert_f16(F, F.x_in, xb, (size_t)M * DM);
    PHASE_END

    PHASE_BEGIN
        for (int l = 0; l < DEPTH; ++l) { unsigned char* wb = F.ws + WS_W + (size_t)l * WL_SIZE;
            NG g{memb, DM, (const f16*)(wb + WL_WKV), DM, 2048, 2048, DM, 1, 1, 0, 0, 0, 0, 0, 0};
            ngemm(F, g, EpF16{(f16*)(wb + WL_KV), 2048, 1.f}); }
    PHASE_END
    PHASE_BEGIN
        for (int l = 0; l < DEPTH; ++l) { unsigned char* wb = F.ws + WS_W + (size_t)l * WL_SIZE;
            const f16* KV = (const f16*)(wb + WL_KV);
            NG g1{KV, 2048, (const f16*)(wb + WL_WQN), DM, 256, DM, 256, 8, 4, (long)256 * 2048, 256, 0, 256, (long)DM * DM, (long)256 * DM};
            ngemm(F, g1, EpF16{(f16*)(wb + WL_GT), DM, 0.0625f});
            NG g2{(const f16*)(wb + WL_WO), DM, KV + 1024, 2048, DM, 256, 256, 8, 4, 0, 256, (long)256 * 2048, 256, (long)DM * DM, 256};
            ngemm(F, g2, EpF16{(f16*)(wb + WL_VWT), DM, 1.f}); }
    PHASE_END

    for (int l = 0; l < DEPTH; ++l) {
        const LayerW L = layer_w(args.in, F.ws, l);
        const float* xres = (l == 0) ? F.x_in : F.out;
        PHASE_BEGIN
            { NG g{xb, DM, (const f16*)(L.wb + WL_WIN), DM, M, NPROJ, DM, 1, 1, 0, 0, 0, 0, 0, 0}; ngemm(F, g, EpF16{proj, NPROJ, 1.f}); }
            n_gates(F, xb, (const float*)(L.wb + WL_WG), L.ml_i_bias, L.ml_f_bias, gates);
        PHASE_END
        PHASE_BEGIN
            n_mlstm(F, L, proj, gates, hmix);
            n_swa(F, L, F.rel_bias, proj, hmix);
        PHASE_END
        PHASE_BEGIN
            { NG g{hmix, DM, (const f16*)(L.wb + WL_WOUT), DM, M, DM, DM, 1, 1, 0, 0, 0, 0, 0, 0}; ngemm(F, g, EpRes{xres, F.out, DM}); }
        PHASE_END
        PHASE_BEGIN
            n_ln(F, F.out, L.ln1_g, L.ln1_b, xb);
        PHASE_END
        PHASE_BEGIN
            { NG g{xb, DM, (const f16*)(L.wb + WL_GT), DM, SEQ, DM, DM, 8, 1, (long)SEQ * DM, 0, (long)DM * DM, 0, (long)SEQ * DM, 0}; ngemm(F, g, EpF32{Sf, DM}); }
        PHASE_END
        PHASE_BEGIN
            n_softmax(F, Sf, Pb);
        PHASE_END
        PHASE_BEGIN
            { NG g{Pb, DM, (const f16*)(L.wb + WL_VWT), DM, SEQ, DM, DM, 8, 1, (long)SEQ * DM, 0, (long)DM * DM, 0, (long)SEQ * DM, 0}; ngemm(F, g, EpRes{F.out, F.out, DM}); }
        PHASE_END
        PHASE_BEGIN
            n_ln(F, F.out, L.ln2_g, L.ln2_b, xb);
        PHASE_END
        for (int c = 0; c < BATCH; ++c) {
            PHASE_BEGIN
                { NG g{xb + (size_t)c * SEQ * DM, DM, (const f16*)(L.wb + WL_WUP), DM, SEQ, DFF2, DM, 1, 1, 0, 0, 0, 0, 0, 0}; ngemm(F, g, EpF16{uchunk, DFF2, 1.f}); }
            PHASE_END
            PHASE_BEGIN
                n_convgelu(F, L, uchunk, c * SEQ, SEQ, hffn);
            PHASE_END
        }
        PHASE_BEGIN
            { NG g{hffn, DFF, (const f16*)(L.wb + WL_WDN), DFF, M, DM, DFF, 1, 1, 0, 0, 0, 0, 0, 0}; ngemm(F, g, EpRes{F.out, F.out, DM}); }
        PHASE_END
        PHASE_BEGIN
            n_ln(F, F.out, L.ln3_g, L.ln3_b, xb);
        PHASE_END
    }
    if (single && hi > 1) { if (__hip_atomic_load(F.ctl + CW_BAR + XB_TMO, RLX_AGENT) != 0u && F.vcu == 0 && F.tid < 64) F.out[F.tid] = __builtin_nanf(""); }
}
constexpr int NPHASES = 3 + DEPTH * (10 + 2 * BATCH);

extern "C" void kernel_launch(void* const* d_in, const int* in_sizes, int n_in, void* d_out, int out_size, void* d_ws, size_t ws_size, hipStream_t stream) {
    static int grid = 0;
    if (grid == 0) {
        if (n_in != 24 || out_size != M * DM || ws_size < WS_END) { fprintf(stderr, "kernel_launch: unexpected shapes (n_in %d out %d ws %zu)\n", n_in, out_size, ws_size); grid = -1; return; }
        int dev = 0, cus = 0;
        if (hipGetDevice(&dev) != hipSuccess || hipDeviceGetAttribute(&cus, hipDeviceAttributeMultiprocessorCount, dev) != hipSuccess) { grid = -1; return; }
        if (hipFuncSetAttribute((const void*)fwd_kernel, hipFuncAttributeMaxDynamicSharedMemorySize, LDS_BYTES) != hipSuccess) { fprintf(stderr, "hipFuncSetAttribute failed\n"); grid = -1; return; }
        (void)hipGetLastError();
        grid = cus;
    }
    if (grid < 0) return;
    hipMemsetAsync((char*)d_ws + WS_CTL, 0, CTL_ZERO_BYTES, stream);
    Args a{};
    for (int i = 0; i < 24; ++i) a.in[i] = d_in[i];
    a.out = (float*)d_out; a.ws = (unsigned char*)d_ws;
#ifndef MK_PER_PHASE
    a.ph_lo = 0; a.ph_hi = NPHASES;
    hipLaunchKernelGGL(fwd_kernel, dim3(grid), dim3(NTHR), LDS_BYTES, stream, a);
#else
    for (int p = 0; p < NPHASES; ++p) { a.ph_lo = p; a.ph_hi = p + 1; hipLaunchKernelGGL(fwd_kernel, dim3(grid), dim3(NTHR), LDS_BYTES, stream, a); }
#endif
}
```

```cpp
#include <hip/hip_runtime.h>
#include <cstdio>
#include <cstdint>

constexpr int DM = 1024, BATCH = 8, SEQ = 4096, M = BATCH * SEQ, DEPTH = 2;
constexpr int NMEM = 256, MLW = 512, MLH = 4, MLD = 128;
constexpr int SWH = 8, SWD = 64, SWKV = 2;
constexpr int NIN = 2824, NPROJ = 2816;
constexpr int DFF = 2816, DFF2 = 5632;
constexpr float ALPHA = 1.41421356237f, EPS = 1e-5f;
constexpr int PC_Q = 0, PC_K = 512, PC_V = 1024, PC_O = 1536, PC_SQ = 2048, PC_SK = 2560, PC_SV = 2688;

typedef _Float16 f16;
typedef _Float16 f16x8 __attribute__((ext_vector_type(8)));
typedef _Float16 f16x4 __attribute__((ext_vector_type(4)));
typedef _Float16 f16x2 __attribute__((ext_vector_type(2)));
typedef float f32x2 __attribute__((ext_vector_type(2)));
typedef float f32x4 __attribute__((ext_vector_type(4)));
typedef float f32x16 __attribute__((ext_vector_type(16)));
typedef unsigned u32x4 __attribute__((ext_vector_type(4)));
typedef unsigned u32x2 __attribute__((ext_vector_type(2)));

#define GAS __attribute__((address_space(1)))
#define LAS __attribute__((address_space(3)))
typedef GAS unsigned gu32;
#define RLX_AGENT __ATOMIC_RELAXED, __HIP_MEMORY_SCOPE_AGENT
#define LDS_WAIT() asm volatile("s_waitcnt lgkmcnt(0)" ::: "memory")
#define VM_WAIT() asm volatile("s_waitcnt vmcnt(0)" ::: "memory")

constexpr size_t MiB = 1u << 20;
constexpr size_t WS_CTL = 0, CTL_ZERO_BYTES = 1 * MiB;
constexpr size_t WL_WIN = 0;
constexpr size_t WL_WG = WL_WIN + (size_t)NPROJ * DM * 2;
constexpr size_t WL_WOUT = WL_WG + 8 * DM * 4;
constexpr size_t WL_WQN = WL_WOUT + (size_t)DM * DM * 2;
constexpr size_t WL_WKV = WL_WQN + (size_t)DM * DM * 2;
constexpr size_t WL_WO = WL_WKV + (size_t)2 * DM * DM * 2;
constexpr size_t WL_WUP = WL_WO + (size_t)DM * DM * 2;
constexpr size_t WL_WDN = WL_WUP + (size_t)DFF2 * DM * 2;
constexpr size_t WL_KV = WL_WDN + (size_t)DM * DFF * 2;
constexpr size_t WL_GT = WL_KV + (size_t)2048 * 2048 * 2;
constexpr size_t WL_VWT = WL_GT + (size_t)8 * DM * DM * 2;
constexpr size_t WL_SIZE = WL_VWT + (size_t)8 * DM * DM * 2;
static_assert(WL_SIZE % 256 == 0, "align");
constexpr size_t WS_W = 1 * MiB;
constexpr size_t WS_MEMB = WS_W + 2 * WL_SIZE;
constexpr size_t WS_GATES = WS_MEMB + (size_t)2048 * DM * 2;
constexpr size_t WS_XB = WS_GATES + (size_t)M * 8 * 4;
constexpr size_t WS_BIG = WS_XB + (size_t)M * DM * 2;
constexpr size_t WS_HMIX = WS_BIG + (size_t)M * NPROJ * 2;
constexpr size_t WS_END = WS_HMIX + (size_t)M * DM * 2;
static_assert(WS_END <= 512 * MiB, "ws");
constexpr int CW_TMO = 0, CW_CODE = 1, CW_BAR = 4096;

#define XB_TMO      128
#define XB_XCNT(j)  (256  + 64 * (j))
#define XB_XSUB(j)  (1280 + 64 * (j))
#define XB_XGEN(j)  (2304 + 64 * (j))
#define XB_TOP      3328
#define XB_TOPGEN   3392
#define XCD_BAR_WORDS 3456
#define XB_SPIN_CAP (1u << 20)
__device__ __forceinline__ unsigned xb_ld(unsigned* p)              { return __hip_atomic_load(p, __ATOMIC_RELAXED, __HIP_MEMORY_SCOPE_AGENT); }
__device__ __forceinline__ unsigned xb_add(unsigned* p, unsigned v) { return __hip_atomic_fetch_add(p, v, __ATOMIC_RELAXED, __HIP_MEMORY_SCOPE_AGENT); }
__device__ __forceinline__ unsigned xb_xcc_id() { return (unsigned)__builtin_amdgcn_s_getreg((3 << 11) | 20) & 0xFu; }
#define XB_SPIN(cond, bar) do { unsigned _sp = 0; while (cond) { __builtin_amdgcn_s_sleep(1); \
    if ((++_sp & 255u) == 0u) { if (xb_ld(&(bar)[XB_TMO])) break; if (_sp > XB_SPIN_CAP) { atomicAdd(&(bar)[XB_TMO], 1u); break; } } } } while (0)
struct XcdBarrier { unsigned* bar; unsigned x; volatile LAS unsigned* st; };
__device__ __forceinline__ XcdBarrier xcd_barrier_post(unsigned* bar, volatile LAS unsigned* st) {
    XcdBarrier b; b.bar = bar; b.x = xb_xcc_id(); b.st = st;
    if (threadIdx.x == 0) (void)xb_add(&bar[XB_XCNT(b.x)], 1u);
    return b;
}
__device__ __forceinline__ void xcd_barrier_complete(unsigned* bar, unsigned x, unsigned& nloc, unsigned& nx) {
    const unsigned G = gridDim.x * gridDim.y * gridDim.z;
    unsigned sum, cnt, mine, sp = 0u;
    for (;;) {
        sum = 0u; cnt = 0u; mine = 0u;
#pragma unroll
        for (unsigned j = 0; j < 16; ++j) { const unsigned c = xb_ld(&bar[XB_XCNT(j)]); sum += c; cnt += (c > 0u) ? 1u : 0u; mine = (j == x) ? c : mine; }
        if (sum == G) break;
        __builtin_amdgcn_s_sleep(1);
        if ((++sp & 255u) == 0u) { if (xb_ld(&bar[XB_TMO])) break; if (sp > XB_SPIN_CAP) { atomicAdd(&bar[XB_TMO], 1u); break; } }
    }
    nloc = mine > 0u ? mine : 1u; nx = cnt > 0u ? cnt : 1u;
}
__device__ __forceinline__ void xcd_barrier(const XcdBarrier& b) {
    asm volatile("s_waitcnt vmcnt(0)" ::: "memory");
    __syncthreads();
    if (threadIdx.x == 0) {
        unsigned* bar = b.bar;
        __builtin_amdgcn_s_waitcnt(0);
        unsigned nloc = b.st[0], nx = b.st[1];
        if (nloc == 0u) { xcd_barrier_complete(bar, b.x, nloc, nx); b.st[0] = nloc; b.st[1] = nx; }
        const unsigned old = xb_add(&bar[XB_XSUB(b.x)], 1u);
        const unsigned gen = old / nloc;
        if (old + 1u == (gen + 1u) * nloc) {
            __builtin_amdgcn_fence(__ATOMIC_RELEASE, "agent");
            asm volatile("s_waitcnt vmcnt(0)" ::: "memory");
            const unsigned og = xb_add(&bar[XB_TOP], 1u);
            const unsigned tg = og / nx;
            if (og + 1u == (tg + 1u) * nx) xb_add(&bar[XB_TOPGEN], 1u);
            else XB_SPIN(xb_ld(&bar[XB_TOPGEN]) == tg, bar);
            __builtin_amdgcn_fence(__ATOMIC_ACQUIRE, "agent");
            xb_add(&bar[XB_XGEN(b.x)], 1u);
            asm volatile("s_waitcnt vmcnt(0)" ::: "memory");
        } else {
            XB_SPIN(xb_ld(&bar[XB_XGEN(b.x)]) == gen, bar);
            __builtin_amdgcn_fence(__ATOMIC_ACQUIRE, "agent");
            asm volatile("s_waitcnt vmcnt(0)" ::: "memory");
        }
    }
    __syncthreads();
}

constexpr int NWAVES = 8, NTHR = 512;
constexpr int RING_BYTES = 131072, LDSCTL_OFF = RING_BYTES, MISC_OFF = LDSCTL_OFF + 320, LDS_BYTES = 147456;
struct LayerW {
    const float *w_in, *ml_conv_w, *ml_conv_b, *ml_i_bias, *ml_f_bias, *ml_norm_g, *swa_sinks, *w_out, *ln1_g, *ln1_b, *xa_wq, *xa_wkv, *xa_wo, *ln2_g, *ln2_b,
                *w_up, *ffn_conv_w, *ffn_conv_b, *w_down, *ln3_g, *ln3_b;
    unsigned char* wb;
};
struct Frame {
    LAS unsigned char* lds;
    volatile LAS unsigned* MISC;
    gu32* ctl;
    int tid, lane, wave, vcu, G, gw, ngw;
    const float *x_in, *mem, *rel_bias; float* out; unsigned char* ws;
};
__device__ __forceinline__ float wave_sum(float v) {
#pragma unroll
    for (int o = 1; o < 64; o <<= 1) v += __shfl_xor(v, o);
    return v;
}
__device__ __forceinline__ float wave_max(float v) {
#pragma unroll
    for (int o = 1; o < 64; o <<= 1) v = fmaxf(v, __shfl_xor(v, o));
    return v;
}
__device__ __forceinline__ unsigned pk2h(float lo, float hi) { f32x2 v = {lo, hi}; f16x2 h = __builtin_convertvector(v, f16x2); return __builtin_bit_cast(unsigned, h); }
__device__ __forceinline__ float siluf(float x) { return x / (1.f + __expf(-x)); }
__device__ __forceinline__ float sigmoidf_(float x) { return 1.f / (1.f + __expf(-x)); }
__device__ __forceinline__ float gelu_tanh(float x) { const float z = 1.5957691216057308f * (x + 0.044715f * x * x * x); return x / (1.f + __expf(-z)); }
__device__ __forceinline__ float logsigmoidf_(float x) { return fminf(x, 0.f) - log1pf(__expf(-fabsf(x))); }

__device__ __forceinline__ LayerW layer_w(void* const* in, unsigned char* ws, int l) {
    LayerW L;
    L.w_in = (const float*)in[3] + (size_t)l * DM * NIN;       L.ml_conv_w = (const float*)in[4] + (size_t)l * 4 * 1024; L.ml_conv_b = (const float*)in[5] + (size_t)l * 1024;
    L.ml_i_bias = (const float*)in[6] + l * 4;                  L.ml_f_bias = (const float*)in[7] + l * 4;                L.ml_norm_g = (const float*)in[8] + l * 512;
    L.swa_sinks = (const float*)in[9] + l * 8;                  L.w_out = (const float*)in[10] + (size_t)l * DM * DM;     L.ln1_g = (const float*)in[11] + l * DM; L.ln1_b = (const float*)in[12] + l * DM;
    L.xa_wq = (const float*)in[13] + (size_t)l * DM * DM;       L.xa_wkv = (const float*)in[14] + (size_t)l * DM * 2 * DM; L.xa_wo = (const float*)in[15] + (size_t)l * DM * DM;
    L.ln2_g = (const float*)in[16] + l * DM;                    L.ln2_b = (const float*)in[17] + l * DM;
    L.w_up = (const float*)in[18] + (size_t)l * DM * DFF2;      L.ffn_conv_w = (const float*)in[19] + (size_t)l * 3 * DFF2; L.ffn_conv_b = (const float*)in[20] + (size_t)l * DFF2;
    L.w_down = (const float*)in[21] + (size_t)l * DFF * DM;     L.ln3_g = (const float*)in[22] + l * DM;                  L.ln3_b = (const float*)in[23] + l * DM;
    L.wb = ws + WS_W + (size_t)l * WL_SIZE;
    return L;
}

__device__ __forceinline__ void transpose_item(const float* W, int ldw, int K, f16* WT, int ns, int nd, int k0, LAS float* scr, int lane) {
#pragma unroll 8
    for (int i = 0; i < 32; ++i) { const int kk = 2 * i + (lane >> 5); scr[kk * 33 + (lane & 31)] = W[(size_t)(k0 + kk) * ldw + ns + (lane & 31)]; }
    LDS_WAIT(); asm volatile("" ::: "memory");
    const int c = lane & 7;
#pragma unroll
    for (int j = 0; j < 4; ++j) { const int n = (lane >> 3) + 8 * j; const LAS float* s = scr + (8 * c) * 33 + n;
        u32x4 o; o.x = pk2h(s[0 * 33], s[1 * 33]); o.y = pk2h(s[2 * 33], s[3 * 33]); o.z = pk2h(s[4 * 33], s[5 * 33]); o.w = pk2h(s[6 * 33], s[7 * 33]);
        *(u32x4*)(WT + (size_t)(nd + n) * K + k0 + 8 * c) = o; }
    LDS_WAIT(); asm volatile("" ::: "memory");
}
template <class Map>
__device__ __forceinline__ void transpose_all(Frame& F, const float* W, int ldw, int K, f16* WT, int ND, Map smap) {
    LAS float* scr = (LAS float*)(F.lds + F.wave * 16384);
    const int ng = ND / 32, nk = K / 64;
    for (int it = F.gw; it < ng * nk; it += F.ngw) { const int g = it % ng, kb = it / ng; transpose_item(W, ldw, K, WT, smap(g * 32), g * 32, kb * 64, scr, F.lane); }
}
__device__ __forceinline__ void convert_f16(Frame& F, const float* src, f16* dst, size_t n) {
    const size_t nv = n / 8;
    for (size_t i = (size_t)F.gw * 64 + F.lane; i < nv; i += (size_t)F.ngw * 64) {
        const f32x4 a = ((const f32x4*)src)[2 * i], b = ((const f32x4*)src)[2 * i + 1];
        u32x4 o; o.x = pk2h(a.x, a.y); o.y = pk2h(a.z, a.w); o.z = pk2h(b.x, b.y); o.w = pk2h(b.z, b.w);
        ((u32x4*)dst)[i] = o;
    }
}

struct NG { const f16* A; long lda; const f16* Bt; long ldb; int Mb, N, K; int nb0, nb1; long sa0, sa1, sb0, sb1, so0, so1; };
template <class Epi>
__device__ __forceinline__ void ngemm(Frame& F, const NG g, const Epi& E) {
    const int tm = g.Mb / 64, tn = g.N / 64, per = tm * tn, total = per * g.nb0 * g.nb1;
    const int r32 = F.lane & 31, hi = F.lane >> 5;
    for (int t = F.gw; t < total; t += F.ngw) {
        const int z = t / per, tt = t % per, pm = tt / tn, pn = tt % tn, z0 = z / g.nb1, z1 = z % g.nb1;
        const f16* Ab = g.A + z0 * g.sa0 + z1 * g.sa1 + (long)(pm * 64 + r32) * g.lda + hi * 8;
        const f16* Bb = g.Bt + z0 * g.sb0 + z1 * g.sb1 + (long)(pn * 64 + r32) * g.ldb + hi * 8;
        f32x16 acc[2][2];
#pragma unroll
        for (int i = 0; i < 2; ++i)
#pragma unroll
            for (int j = 0; j < 2; ++j)
#pragma unroll
                for (int r = 0; r < 16; ++r) acc[i][j][r] = 0.f;
        for (int k = 0; k < g.K; k += 16) {
            const f16x8 a0 = *(const f16x8*)(Ab + k), a1 = *(const f16x8*)(Ab + 32 * g.lda + k);
            const f16x8 b0 = *(const f16x8*)(Bb + k), b1 = *(const f16x8*)(Bb + 32 * g.ldb + k);
            acc[0][0] = __builtin_amdgcn_mfma_f32_32x32x16_f16(b0, a0, acc[0][0], 0, 0, 0);
            acc[0][1] = __builtin_amdgcn_mfma_f32_32x32x16_f16(b1, a0, acc[0][1], 0, 0, 0);
            acc[1][0] = __builtin_amdgcn_mfma_f32_32x32x16_f16(b0, a1, acc[1][0], 0, 0, 0);
            acc[1][1] = __builtin_amdgcn_mfma_f32_32x32x16_f16(b1, a1, acc[1][1], 0, 0, 0);
        }
        const long ooff = z0 * g.so0 + z1 * g.so1;
#pragma unroll
        for (int i = 0; i < 2; ++i)
#pragma unroll
            for (int j = 0; j < 2; ++j)
#pragma unroll
                for (int q = 0; q < 4; ++q) {
                    const f32x4 v = {acc[i][j][4 * q], acc[i][j][4 * q + 1], acc[i][j][4 * q + 2], acc[i][j][4 * q + 3]};
                    E(ooff, pm * 64 + 32 * i + r32, pn * 64 + 32 * j + 8 * q + 4 * hi, v);
                }
    }
}
struct EpF16 { f16* O; long ldo; float scale;
    __device__ __forceinline__ void operator()(long ooff, int row, int col, f32x4 v) const { u32x2 w; w.x = pk2h(v.x * scale, v.y * scale); w.y = pk2h(v.z * scale, v.w * scale); *(u32x2*)(O + ooff + (long)row * ldo + col) = w; } };
struct EpF32 { float* O; long ldo;
    __device__ __forceinline__ void operator()(long ooff, int row, int col, f32x4 v) const { *(f32x4*)(O + ooff + (long)row * ldo + col) = v; } };
struct EpRes { const float* X; float* O; long ldo;
    __device__ __forceinline__ void operator()(long ooff, int row, int col, f32x4 v) const { const f32x4 x = *(const f32x4*)(X + ooff + (long)row * ldo + col); *(f32x4*)(O + ooff + (long)row * ldo + col) = x * ALPHA + v; } };

namespace pg8 {
constexpr int BM = 256, BK = 64, HALF = 128, HTB = HALF * BK * 2, STAGE_BYTES = 8 * HTB, NXCD = 8, WGM = 8;
__host__ __device__ __forceinline__ int lds_byte(int r, int c) { const int st = (r >> 4) * 2 + (c >> 5), rr = r & 15, cc = c & 31, ob = rr * 64 + cc * 2; return st * 1024 + (ob ^ (((ob >> 9) & 1) << 5)); }
__host__ __device__ __forceinline__ void stage_rc(int b, int& R, int& C) { const int st = b / 1024, sb = b % 1024, swz = sb ^ (((sb >> 9) & 1) << 5); R = (st >> 1) * 16 + swz / 64; C = (st & 1) * 32 + (swz % 64) / 2; }
__host__ __device__ __forceinline__ int perm32(int rho) { const int n = rho >> 4, i = rho & 15; return 8 * (i >> 2) + 4 * n + (i & 3); }
struct Unit { int pm, pn; const char* a; const char* b; long ooff; };
struct Geo { int lda, ldb, K; };
__device__ __forceinline__ void static_map(int L, int nM, int nN, int& pm, int& pn) {
    const int nwg = nM * nN; int wgid = L; { const int q = nwg / NXCD, r = nwg % NXCD, xcd = wgid % NXCD, off = wgid / NXCD; wgid = (xcd < r ? xcd * (q + 1) : r * (q + 1) + (xcd - r) * q) + off; }
    const int nig = WGM * nN, gid = wgid / nig, fm = gid * WGM, gsz = (nM - fm) < WGM ? (nM - fm) : WGM;
    pm = fm + ((wgid % nig) % gsz); pn = (wgid % nig) / gsz;
}
template <class Fn> struct FnSched { int n, G, c; Fn f;
    __device__ __forceinline__ bool next(int i, Unit& u) const { const long L = (long)i * G + c; if (L >= n) return false; f((int)L, u); return true; } };
template <class Fn> __device__ __forceinline__ FnSched<Fn> make_sched(int n, Fn f) { return FnSched<Fn>{n, (int)gridDim.x, (int)blockIdx.x, f}; }

typedef f32x4 Acc[2][2][4][2];
struct EpiF16 { static constexpr bool PERM = true; f16* O; int ldc; float sc;
    __device__ __forceinline__ void operator()(Acc& acc, const Unit& u, int wr, int wc, int fr, int fq, LAS unsigned char*, int, int) const {
        f16* base = O + u.ooff + (size_t)(u.pm * BM + wr * 64 + fr) * ldc + u.pn * BM + wc * 32 + 8 * fq;
#pragma unroll
        for (int ai = 0; ai < 2; ++ai)
#pragma unroll
            for (int m = 0; m < 4; ++m) { f16* rowp = base + (size_t)(ai * HALF + m * 16) * ldc;
#pragma unroll
                for (int bj = 0; bj < 2; ++bj) { const f32x4 v0 = acc[ai][bj][m][0] * sc, v1 = acc[ai][bj][m][1] * sc;
                    u32x4 w; w.x = pk2h(v0[0], v0[1]); w.y = pk2h(v0[2], v0[3]); w.z = pk2h(v1[0], v1[1]); w.w = pk2h(v1[2], v1[3]);
                    *(u32x4*)(rowp + bj * HALF) = w; } }
    } };
struct EpiF32 { static constexpr bool PERM = false; float* O; int ldc;
    __device__ __forceinline__ void operator()(Acc& acc, const Unit& u, int wr, int wc, int fr, int fq, LAS unsigned char*, int, int) const {
        float* base = O + u.ooff + (size_t)(u.pm * BM + wr * 64 + fr) * ldc + u.pn * BM + wc * 32 + 4 * fq;
#pragma unroll
        for (int ai = 0; ai < 2; ++ai)
#pragma unroll
            for (int m = 0; m < 4; ++m) { float* rowp = base + (size_t)(ai * HALF + m * 16) * ldc;
#pragma unroll
                for (int bj = 0; bj < 2; ++bj)
#pragma unroll
                    for (int n = 0; n < 2; ++n) *(f32x4*)(rowp + bj * HALF + n * 16) = acc[ai][bj][m][n]; }
    } };
struct EpiRes { static constexpr bool PERM = false; const float* X; float* O; int ldc;
    __device__ __forceinline__ void operator()(Acc& acc, const Unit& u, int wr, int wc, int fr, int fq, LAS unsigned char*, int, int) const {
        const size_t off0 = u.ooff + (size_t)(u.pm * BM + wr * 64 + fr) * ldc + u.pn * BM + wc * 32 + 4 * fq;
#pragma unroll
        for (int ai = 0; ai < 2; ++ai)
#pragma unroll
            for (int m = 0; m < 4; ++m) { const size_t off = off0 + (size_t)(ai * HALF + m * 16) * ldc;
#pragma unroll
                for (int bj = 0; bj < 2; ++bj)
#pragma unroll
                    for (int n = 0; n < 2; ++n) { const f32x4 x = *(const f32x4*)(X + off + bj * HALF + n * 16); *(f32x4*)(O + off + bj * HALF + n * 16) = x * ALPHA + acc[ai][bj][m][n]; } }
    } };

template <class Epi, class Sched, bool ALIGN_EPI>
__device__ __forceinline__ void gemm_phase(LAS unsigned char* lds, const Geo g, const Sched& S, const Epi& E) {
    int tid_ = threadIdx.x; asm volatile("" : "+v"(tid_));
    const int tid = tid_, wid = __builtin_amdgcn_readfirstlane(tid >> 6), lane = tid & 63, wr = wid >> 2, wc = wid & 3, fr = lane & 15, fq = lane >> 4;
    const int nt = g.K / BK;
    unsigned voffA[2], voffB[2];
#pragma unroll
    for (int i = 0; i < 2; ++i) { int R, C; stage_rc(tid * 16 + i * 8192, R, C); const int Rb = Epi::PERM ? ((R & ~31) + perm32(R & 31)) : R;
        voffA[i] = (unsigned)(R * g.lda + C) * 2u; voffB[i] = (unsigned)(Rb * g.ldb + C) * 2u; }
    const size_t kstep = (size_t)(BK * 2);
    const size_t hstepA = (size_t)HALF * g.lda * 2, hstepB = (size_t)HALF * g.ldb * 2;
    const unsigned ldsw = (unsigned)wid * 1024u;
    const int aoff = lds_byte(wr * 64 + fr, fq * 8), boff = lds_byte(wc * 32 + fr, fq * 8);
#define PG8_SA(b, h) (((b) * 2 + (h)) * HTB)
#define PG8_SB(b, h) ((4 + (b) * 2 + (h)) * HTB)
#define PG8_STAGE(bufoff, gbase, voff) do { _Pragma("unroll") for (int _i = 0; _i < 2; ++_i) \
        __builtin_amdgcn_global_load_lds((const unsigned*)((const char*)(gbase) + (voff)[_i]), (LAS unsigned*)(lds + (bufoff) + ldsw + _i * 8192), 16, 0, 0); } while (0)
#define PG8_LDA(dst, b, h) do { _Pragma("unroll") for (int m = 0; m < 4; ++m) _Pragma("unroll") for (int k = 0; k < 2; ++k) dst[m][k] = *(const LAS f16x8*)(lds + PG8_SA(b, h) + aoff + m * 2048 + k * 1024); } while (0)
#define PG8_LDB(dst, b, h) do { _Pragma("unroll") for (int n = 0; n < 2; ++n) _Pragma("unroll") for (int k = 0; k < 2; ++k) dst[n][k] = *(const LAS f16x8*)(lds + PG8_SB(b, h) + boff + n * 2048 + k * 1024); } while (0)
#define PG8_MMA(ai, bj, At, Bt) do { __builtin_amdgcn_s_setprio(1); _Pragma("unroll") for (int m = 0; m < 4; ++m) _Pragma("unroll") for (int n = 0; n < 2; ++n) _Pragma("unroll") for (int k = 0; k < 2; ++k) \
        acc[ai][bj][m][n] = __builtin_amdgcn_mfma_f32_16x16x32_f16(Bt[n][k], At[m][k], acc[ai][bj][m][n], 0, 0, 0); __builtin_amdgcn_s_setprio(0); } while (0)
#define PG8_WAIT_V(n) asm volatile("s_waitcnt vmcnt(" #n ")" ::: "memory")
#define PG8_WAIT_L(n) asm volatile("s_waitcnt lgkmcnt(" #n ")" ::: "memory")
#define PG8_BAR __builtin_amdgcn_s_barrier()
#define PG8_SCHED __builtin_amdgcn_sched_barrier(0)
    Unit cur, nxt; int ui = 0;
    if (!S.next(0, cur)) return;
    Acc acc;
#pragma unroll
    for (int a = 0; a < 2; ++a)
#pragma unroll
        for (int b = 0; b < 2; ++b)
#pragma unroll
            for (int m = 0; m < 4; ++m)
#pragma unroll
                for (int n = 0; n < 2; ++n) acc[a][b][m][n] = (f32x4){0.f, 0.f, 0.f, 0.f};
    f16x8 At[4][2], B0[2][2], B1[2][2];
    const char* cA = cur.a; const char* cB = cur.b;
    PG8_STAGE(PG8_SB(0, 0), cB, voffB); PG8_STAGE(PG8_SB(0, 1), cB + hstepB, voffB); PG8_STAGE(PG8_SA(0, 0), cA, voffA); PG8_STAGE(PG8_SA(0, 1), cA + hstepA, voffA);
    if (wr == 1) PG8_BAR;
    PG8_WAIT_V(2); PG8_BAR;
    PG8_STAGE(PG8_SB(1, 0), cB + kstep, voffB); PG8_STAGE(PG8_SA(1, 0), cA + kstep, voffA); PG8_STAGE(PG8_SB(1, 1), cB + hstepB + kstep, voffB);
    PG8_WAIT_V(6); PG8_BAR;
    for (;;) {
        const bool has_next = S.next(ui + 1, nxt);
        const char* nA = has_next ? nxt.a : cA; const char* nB = has_next ? nxt.b : cB;
        for (int t = 0; t < nt; t += 2) {
            const bool last = (t == nt - 2);
            const char* a1 = cA + (size_t)(t + 1) * kstep;
            const char* a2 = last ? nA : cA + (size_t)(t + 2) * kstep; const char* b2 = last ? nB : cB + (size_t)(t + 2) * kstep;
            const char* a3 = a2 + kstep; const char* b3 = b2 + kstep;
            PG8_LDB(B0, 0, 0); PG8_LDB(B1, 0, 1); PG8_SCHED; PG8_LDA(At, 0, 0); PG8_STAGE(PG8_SA(1, 1), a1 + hstepA, voffA);
            PG8_WAIT_V(8); PG8_WAIT_L(0); PG8_BAR; PG8_MMA(0, 0, At, B0); PG8_MMA(0, 1, At, B1); PG8_BAR; PG8_SCHED;
            PG8_LDA(At, 0, 1); PG8_STAGE(PG8_SB(0, 0), b2, voffB); PG8_STAGE(PG8_SB(0, 1), b2 + hstepB, voffB); PG8_STAGE(PG8_SA(0, 0), a2, voffA);
            PG8_WAIT_V(8); PG8_WAIT_L(0); PG8_BAR; PG8_MMA(1, 0, At, B0); PG8_MMA(1, 1, At, B1); PG8_BAR; PG8_SCHED;
            PG8_LDB(B0, 1, 0); PG8_LDB(B1, 1, 1); PG8_SCHED; PG8_LDA(At, 1, 0); PG8_STAGE(PG8_SA(0, 1), a2 + hstepA, voffA);
            PG8_WAIT_V(8); PG8_WAIT_L(0); PG8_BAR; PG8_MMA(0, 0, At, B0); PG8_MMA(0, 1, At, B1); PG8_BAR; PG8_SCHED;
            PG8_LDA(At, 1, 1); PG8_STAGE(PG8_SB(1, 0), b3, voffB); PG8_STAGE(PG8_SB(1, 1), b3 + hstepB, voffB); PG8_STAGE(PG8_SA(1, 0), a3, voffA);
            PG8_WAIT_V(8); PG8_WAIT_L(0); PG8_BAR; PG8_MMA(1, 0, At, B0); PG8_MMA(1, 1, At, B1); PG8_BAR; PG8_SCHED;
        }
        if constexpr (ALIGN_EPI) { if (wr == 0) PG8_BAR; }
        E(acc, cur, wr, wc, fr, fq, lds, wid, lane);
        if (!has_next) break;
#pragma unroll
        for (int a = 0; a < 2; ++a)
#pragma unroll
            for (int b = 0; b < 2; ++b)
#pragma unroll
                for (int m = 0; m < 4; ++m)
#pragma unroll
                    for (int n = 0; n < 2; ++n) acc[a][b][m][n] = (f32x4){0.f, 0.f, 0.f, 0.f};
        cur = nxt; cA = nA; cB = nB; ++ui;
        if constexpr (ALIGN_EPI) { if (wr == 1) PG8_BAR; }
    }
    PG8_WAIT_V(0);
    if constexpr (!ALIGN_EPI) { if (wr == 0) PG8_BAR; }
    PG8_BAR;
#undef PG8_SA
#undef PG8_SB
#undef PG8_STAGE
#undef PG8_LDA
#undef PG8_LDB
#undef PG8_MMA
#undef PG8_WAIT_V
#undef PG8_WAIT_L
#undef PG8_BAR
#undef PG8_SCHED
}
__device__ __forceinline__ auto flat_sched(const f16* A, int lda, const f16* Bt, int ldb, int nM, int nN, int tpb, size_t bstr) {
    return make_sched(nM * nN, [=](int L, Unit& u) { static_map(L, nM, nN, u.pm, u.pn); u.a = (const char*)A + (size_t)u.pm * BM * lda * 2; u.b = (const char*)Bt + (size_t)(u.pm / tpb) * bstr + (size_t)u.pn * BM * ldb * 2; u.ooff = 0; });
}
}

__device__ __forceinline__ void n_ln(Frame& F, float* X, const float* g, const float* b, f16* XB) {
    for (int m = F.gw; m < M; m += F.ngw) {
        f32x4* xr = (f32x4*)(X + (size_t)m * DM) + F.lane;
        f32x4 v[4]; float s = 0.f;
#pragma unroll
        for (int j = 0; j < 4; ++j) { v[j] = xr[64 * j]; s += (v[j].x + v[j].y) + (v[j].z + v[j].w); }
        const float mean = wave_sum(s) * (1.f / DM); float s2 = 0.f;
#pragma unroll
        for (int j = 0; j < 4; ++j) { v[j] = v[j] - mean; s2 += (v[j].x * v[j].x + v[j].y * v[j].y) + (v[j].z * v[j].z + v[j].w * v[j].w); }
        const float rstd = 1.f / sqrtf(wave_sum(s2) * (1.f / DM) + EPS);
        u32x2* o8 = (u32x2*)(XB + (size_t)m * DM) + F.lane;
#pragma unroll
        for (int j = 0; j < 4; ++j) { const f32x4 gg = ((const f32x4*)g)[F.lane + 64 * j], bb = ((const f32x4*)b)[F.lane + 64 * j];
            const f32x4 o = v[j] * rstd * gg + bb; xr[64 * j] = o; u32x2 w; w.x = pk2h(o.x, o.y); w.y = pk2h(o.z, o.w); o8[64 * j] = w; }
    }
}
__device__ __forceinline__ void n_gates(Frame& F, const f16* XB, const float* Wg, const float* ib, const float* fb, float* gates) {
    for (int m = F.gw; m < M; m += F.ngw) {
        float xs[16];
#pragma unroll
        for (int j = 0; j < 2; ++j) { const f16x8 xv = *(const f16x8*)(XB + (size_t)m * DM + j * 512 + F.lane * 8);
#pragma unroll
            for (int e = 0; e < 8; ++e) xs[j * 8 + e] = (float)xv[e]; }
        float acc[8];
#pragma unroll
        for (int c = 0; c < 8; ++c) { float a = 0.f;
#pragma unroll
            for (int j = 0; j < 2; ++j)
#pragma unroll
                for (int e = 0; e < 8; ++e) a += xs[j * 8 + e] * Wg[c * DM + j * 512 + F.lane * 8 + e];
            acc[c] = wave_sum(a); }
        if (F.lane < 8) { float v = 0.f;
#pragma unroll
            for (int c = 0; c < 8; ++c) if (F.lane == c) v = acc[c];
            v += (F.lane < 4) ? ib[F.lane] : fb[F.lane - 4]; gates[(size_t)m * 8 + F.lane] = v; }
    }
}
__device__ __forceinline__ void n_mlstm(Frame& F, const LayerW& L, const f16* proj, const float* gates, f16* hmix) {
    LAS float* sq = (LAS float*)F.lds; LAS float* sk = sq + 128; LAS float* sv = sk + 128; LAS float* part = sv + 128; LAS float* red = part + 512;
    const int tid = F.tid, e = tid & 127, dq = tid >> 7;
    for (int bh = F.vcu; bh < BATCH * MLH; bh += F.G) {
        const int b = bh / MLH, h = bh % MLH;
        float c[32]; float nn = 0.f, mst = 0.f;
#pragma unroll
        for (int i = 0; i < 32; ++i) c[i] = 0.f;
        float cw[4], cb = 0.f; int ccol = 0;
        if (tid < 256) { const int which = tid >> 7, d = tid & 127; ccol = which * 512 + h * 128 + d; cb = L.ml_conv_b[ccol];
#pragma unroll
            for (int j = 0; j < 4; ++j) cw[j] = L.ml_conv_w[j * 1024 + ccol]; }
        const float ng = (tid < 128) ? L.ml_norm_g[h * 128 + e] : 0.f;
        for (int t = 0; t < SEQ; ++t) {
            const size_t row = (size_t)b * SEQ + t;
            if (tid < 256) { float a = cb;
#pragma unroll
                for (int j = 0; j < 4; ++j) { const int tt = t - 3 + j; if (tt >= 0) a += cw[j] * (float)proj[(row - 3 + j) * NPROJ + ccol]; }
                a = siluf(a); if (tid >= 128) { a *= 0.08838834764831845f; sk[tid & 127] = a; } else sq[tid] = a;
            } else if (tid < 384) { sv[tid - 256] = (float)proj[row * NPROJ + PC_V + h * 128 + (tid - 256)]; }
            const float ig = gates[row * 8 + h], lf = logsigmoidf_(gates[row * 8 + 4 + h]);
            const float mnew = fmaxf(lf + mst, ig), fg = __expf(lf + mst - mnew), ii = __expf(ig - mnew); mst = mnew;
            __syncthreads();
            const float ve = sv[e] * ii; float p = 0.f;
#pragma unroll
            for (int i = 0; i < 32; ++i) { const int d = 32 * dq + i; c[i] = fg * c[i] + sk[d] * ve; p += sq[d] * c[i]; }
            part[dq * 128 + e] = p;
            if (tid < 128) { nn = fg * nn + ii * sk[tid]; const float dp = wave_sum(sq[tid] * nn); if (F.lane == 0) red[F.wave] = dp; }
            __syncthreads();
            float hv = 0.f;
            if (tid < 128) { const float num = (part[e] + part[128 + e]) + (part[256 + e] + part[384 + e]); const float den = red[0] + red[1];
                hv = num / fmaxf(fabsf(den), __expf(-mst)); const float s1 = wave_sum(hv); if (F.lane == 0) red[4 + F.wave] = s1; }
            __syncthreads();
            float dv = 0.f;
            if (tid < 128) { const float mu = (red[4] + red[5]) * (1.f / 128.f); dv = hv - mu; const float s2 = wave_sum(dv * dv); if (F.lane == 0) red[8 + F.wave] = s2; }
            __syncthreads();
            if (tid < 128) { const float var = (red[8] + red[9]) * (1.f / 128.f); const float hn = dv * rsqrtf(var + EPS) * ng;
                const float og = sigmoidf_((float)proj[row * NPROJ + PC_O + h * 128 + e]); hmix[row * DM + h * 128 + e] = (f16)(og * hn); }
        }
        __syncthreads();
    }
}
namespace ml {
typedef short v4i16 __attribute__((ext_vector_type(4)));
constexpr int RS = 272, SRS = 144;
constexpr int QS = 0, KS = 64 * RS, VS = 2 * 64 * RS, SS = 3 * 64 * RS, FS = SS + 64 * SRS;
constexpr int F_BC = 0, F_U = 64, F_MT = 128, F_WINT = 192, F_WK = 256, F_DEN = 320, F_NV = 384  , F_STP = 640  , F_STF = 1664  , F_MISC = 1792, F_END = 1808;
static_assert(FS % 16 == 0 && FS + F_END * 4 <= RING_BYTES, "mlstm lds");
__device__ __forceinline__ f16x4 tr4(LAS unsigned char* p) { return __builtin_bit_cast(f16x4, __builtin_amdgcn_ds_read_tr16_b64_v4i16((LAS v4i16*)p)); }
__device__ __forceinline__ f16x8 cat8(f16x4 a, f16x4 b) { return (f16x8){a[0], a[1], a[2], a[3], b[0], b[1], b[2], b[3]}; }
__device__ __forceinline__ float sum16(float v) { v += __shfl_xor(v, 1); v += __shfl_xor(v, 2); v += __shfl_xor(v, 4); v += __shfl_xor(v, 8); return v; }
__device__ __forceinline__ float sum8(float v) { v += __shfl_xor(v, 1); v += __shfl_xor(v, 2); v += __shfl_xor(v, 4); return v; }

__device__ __forceinline__ void mlstm_chunks(Frame& F, const LayerW& L, const f16* proj, const float* gates, f16* hmix, int b, int h, int c0, int nch, f32x4 (&Cacc)[8]) {
    LAS unsigned char* lds = F.lds; LAS float* fs = (LAS float*)(lds + FS);
    const int tid = F.tid, lane = F.lane, w = F.wave, i16 = lane & 15, g = lane >> 4;
    const int cp = tid & 127, rg = tid >> 7, c2 = 2 * cp, which = c2 >> 7, dcol = c2 & 127, ccol = which * 512 + h * 128 + dcol;
    float cw0[4], cw1[4]; const float cb0 = L.ml_conv_b[ccol], cb1 = L.ml_conv_b[ccol + 1];
#pragma unroll
    for (int j = 0; j < 4; ++j) { cw0[j] = L.ml_conv_w[j * 1024 + ccol]; cw1[j] = L.ml_conv_w[j * 1024 + ccol + 1]; }
    const float kscale = which ? 0.08838834764831845f : 1.f;
    const int ecol = h * 128 + 16 * w + i16; const float ng = L.ml_norm_g[ecol];
    int nb = 0;
    for (int c = c0; c < c0 + nch; ++c) {
        const size_t row0 = (size_t)b * SEQ + (size_t)c * 64;
        const float m_prev = fs[F_MISC];
        { const f16* src = proj + row0 * NPROJ + ccol; float p0[3], p1[3];
#pragma unroll
          for (int rr = 0; rr < 3; ++rr) { const int tl = 16 * rg - 3 + rr; if (c * 64 + tl >= 0) { const f16x2 v = *(const f16x2*)(src + (long)tl * NPROJ); p0[rr] = (float)v[0]; p1[rr] = (float)v[1]; } else { p0[rr] = 0.f; p1[rr] = 0.f; } }
          LAS unsigned char* dst = lds + (which ? KS : QS) + dcol * 2;
#pragma unroll
          for (int r = 0; r < 16; ++r) { const f16x2 v = *(const f16x2*)(src + (long)(16 * rg + r) * NPROJ); const float x0 = (float)v[0], x1 = (float)v[1];
              const float a0 = cb0 + cw0[0] * p0[0] + cw0[1] * p0[1] + cw0[2] * p0[2] + cw0[3] * x0, a1 = cb1 + cw1[0] * p1[0] + cw1[1] * p1[1] + cw1[2] * p1[2] + cw1[3] * x1;
              p0[0] = p0[1]; p0[1] = p0[2]; p0[2] = x0; p1[0] = p1[1]; p1[1] = p1[2]; p1[2] = x1;
              *(LAS unsigned*)(dst + (16 * rg + r) * RS) = pk2h(siluf(a0) * kscale, siluf(a1) * kscale); } }
        { const int r = tid >> 3, sg = tid & 7; const f16* vs = proj + (row0 + r) * NPROJ + PC_V + h * 128 + sg * 16;
          const u32x4 v0 = *(const u32x4*)vs, v1 = *(const u32x4*)(vs + 8); *(LAS u32x4*)(lds + VS + r * RS + sg * 32) = v0; *(LAS u32x4*)(lds + VS + r * RS + sg * 32 + 16) = v1; }
        if (w == 0) {
            const float ig = gates[(row0 + lane) * 8 + h], lf = logsigmoidf_(gates[(row0 + lane) * 8 + 4 + h]);
            float bc = lf;
#pragma unroll
            for (int o = 1; o < 64; o <<= 1) { const float t = __shfl_up(bc, o); if (lane >= o) bc += t; }
            const float u = ig - bc; float cm = u;
#pragma unroll
            for (int o = 1; o < 64; o <<= 1) { const float t = __shfl_up(cm, o); if (lane >= o) cm = fmaxf(cm, t); }
            const float Mt = fmaxf(m_prev, cm), wint = __expf(m_prev - Mt), gtot = __shfl(bc, 63), a = gtot + u, amax = wave_max(a);
            const float m_new = fmaxf(gtot + m_prev, amax), decay = __expf(gtot + m_prev - m_new), wk = __expf(a - m_new);
            fs[F_BC + lane] = bc; fs[F_U + lane] = u; fs[F_MT + lane] = Mt; fs[F_WINT + lane] = wint; fs[F_WK + lane] = wk;
            if (lane == 0) { fs[F_MISC + 2] = m_new; fs[F_MISC + 1] = decay; }
        }
        __syncthreads();
        { const int tt = w >> 1, st0 = 2 * (w & 1);
#pragma unroll
          for (int j = 0; j < 2; ++j) { const int st = st0 + j; f32x4 acc = {0.f, 0.f, 0.f, 0.f};
              if (st <= tt) {
#pragma unroll
                  for (int kd = 0; kd < 4; ++kd) { const f16x8 a = *(const LAS f16x8*)(lds + QS + (16 * tt + i16) * RS + (32 * kd + 8 * g) * 2), bb = *(const LAS f16x8*)(lds + KS + (16 * st + i16) * RS + (32 * kd + 8 * g) * 2);
                      acc = __builtin_amdgcn_mfma_f32_16x16x32_f16(a, bb, acc, 0, 0, 0); }
                  const int sc = 16 * st + i16; const float us = fs[F_U + sc];
#pragma unroll
                  for (int r = 0; r < 4; ++r) { const int t = 16 * tt + 4 * g + r; acc[r] = (sc <= t) ? acc[r] * __expf(us - fs[F_MT + t]) : 0.f; }
              }
#pragma unroll
              for (int r = 0; r < 4; ++r) *(LAS f16*)(lds + SS + (16 * tt + 4 * g + r) * SRS + (16 * st + i16) * 2) = (f16)acc[r]; } }
        __syncthreads();
        f32x4 num[4]; f16x8 Vf[2];
        { f16x8 Cf[4];
#pragma unroll
          for (int i2 = 0; i2 < 4; ++i2) { const f32x4 x = Cacc[2 * i2], y = Cacc[2 * i2 + 1]; Cf[i2] = (f16x8){(f16)x[0], (f16)x[1], (f16)x[2], (f16)x[3], (f16)y[0], (f16)y[1], (f16)y[2], (f16)y[3]}; }
#pragma unroll
          for (int tt = 0; tt < 4; ++tt) { f32x4 acc = {0.f, 0.f, 0.f, 0.f};
#pragma unroll
              for (int i2 = 0; i2 < 4; ++i2) { const LAS unsigned char* qp = lds + QS + (16 * tt + i16) * RS + (32 * i2 + 4 * g) * 2;
                  acc = __builtin_amdgcn_mfma_f32_16x16x32_f16(cat8(*(const LAS f16x4*)qp, *(const LAS f16x4*)(qp + 32)), Cf[i2], acc, 0, 0, 0); }
#pragma unroll
              for (int r = 0; r < 4; ++r) acc[r] *= fs[F_WINT + 16 * tt + 4 * g + r];
              num[tt] = acc; } }
#pragma unroll
        for (int ks = 0; ks < 2; ++ks) { LAS unsigned char* vp = lds + VS + (32 * ks + 8 * g + (i16 >> 2)) * RS + (16 * w + 4 * (i16 & 3)) * 2; Vf[ks] = cat8(tr4(vp), tr4(vp + 4 * RS)); }
#pragma unroll
        for (int tt = 0; tt < 4; ++tt)
#pragma unroll
            for (int ks = 0; ks < 2; ++ks) if (32 * ks <= 16 * tt + 15) { const f16x8 a = *(const LAS f16x8*)(lds + SS + (16 * tt + i16) * SRS + (32 * ks + 8 * g) * 2); num[tt] = __builtin_amdgcn_mfma_f32_16x16x32_f16(a, Vf[ks], num[tt], 0, 0, 0); }
        { const int t = 8 * w + (lane >> 3), part = lane & 7; const LAS unsigned char* qp = lds + QS + t * RS + part * 32; const LAS float* np_ = fs + F_NV + nb * 128 + part * 16;
          const f16x8 q0 = *(const LAS f16x8*)qp, q1 = *(const LAS f16x8*)(qp + 16); float dq = 0.f;
#pragma unroll
          for (int e = 0; e < 8; ++e) dq += (float)q0[e] * np_[e] + (float)q1[e] * np_[8 + e];
          const f16x8 sv = *(const LAS f16x8*)(lds + SS + t * SRS + part * 16); float rs = 0.f;
#pragma unroll
          for (int e = 0; e < 8; ++e) rs += (float)sv[e];
          dq = sum8(dq); rs = sum8(rs);
          if (part == 0) fs[F_DEN + t] = fs[F_WINT + t] * dq + rs; }
        __syncthreads();
        { const float decay = fs[F_MISC + 1]; f16x8 wk8[2];
#pragma unroll
          for (int ks = 0; ks < 2; ++ks) { const f32x4 x = *(const LAS f32x4*)(fs + F_WK + 32 * ks + 8 * g), y = *(const LAS f32x4*)(fs + F_WK + 32 * ks + 8 * g + 4);
              wk8[ks] = (f16x8){(f16)x[0], (f16)x[1], (f16)x[2], (f16)x[3], (f16)y[0], (f16)y[1], (f16)y[2], (f16)y[3]}; }
#pragma unroll
          for (int dd = 0; dd < 8; ++dd) { f32x4 acc = Cacc[dd] * decay;
#pragma unroll
              for (int ks = 0; ks < 2; ++ks) { LAS unsigned char* kp = lds + KS + (32 * ks + 8 * g + (i16 >> 2)) * RS + (16 * dd + 4 * (i16 & 3)) * 2;
                  const f16x8 a = cat8(tr4(kp), tr4(kp + 4 * RS)) * wk8[ks]; acc = __builtin_amdgcn_mfma_f32_16x16x32_f16(a, Vf[ks], acc, 0, 0, 0); }
              Cacc[dd] = acc; }
          const int d = 16 * w + i16; float pn = 0.f;
#pragma unroll
          for (int ss = 0; ss < 16; ++ss) pn += fs[F_WK + 16 * g + ss] * (float)*(const LAS f16*)(lds + KS + (16 * g + ss) * RS + d * 2);
          pn += __shfl_xor(pn, 16); pn += __shfl_xor(pn, 32);
          if (g == 0) fs[F_NV + (nb ^ 1) * 128 + d] = decay * fs[F_NV + nb * 128 + d] + pn; }
#pragma unroll
        for (int tt = 0; tt < 4; ++tt)
#pragma unroll
            for (int r = 0; r < 4; ++r) { const int t = 16 * tt + 4 * g + r; const float den = fs[F_DEN + t], mt = fs[F_BC + t] + fs[F_MT + t];
                const float hv = num[tt][r] / fmaxf(fabsf(den), __expf(-mt)); num[tt][r] = hv;
                const float s1 = sum16(hv), s2 = sum16(hv * hv); if (i16 == 0) *(LAS f32x2*)(fs + F_STP + (w * 64 + t) * 2) = (f32x2){s1, s2}; }
        __syncthreads();
        { const int t = 8 * w + (lane >> 3), part = lane & 7; const f32x2 p = *(const LAS f32x2*)(fs + F_STP + (part * 64 + t) * 2);
          const float s1 = sum8(p.x), s2 = sum8(p.y), mean = s1 * (1.f / 128.f), var = fmaxf(s2 * (1.f / 128.f) - mean * mean, 0.f);
          if (part == 0) *(LAS f32x2*)(fs + F_STF + t * 2) = (f32x2){mean, rsqrtf(var + EPS)};
          if (tid == 0) fs[F_MISC] = fs[F_MISC + 2]; }
        __syncthreads();
#pragma unroll
        for (int tt = 0; tt < 4; ++tt)
#pragma unroll
            for (int r = 0; r < 4; ++r) { const int t = 16 * tt + 4 * g + r; const f32x2 st = *(const LAS f32x2*)(fs + F_STF + t * 2);
                const float og = sigmoidf_((float)proj[(row0 + t) * NPROJ + PC_O + ecol]);
                hmix[(row0 + t) * DM + ecol] = (f16)((num[tt][r] - st.x) * st.y * ng * og); }
        nb ^= 1;
    }
}
__device__ __forceinline__ void mlstm_seq(Frame& F, const LayerW& L, const f16* proj, const float* gates, f16* hmix) {
    LAS float* fs = (LAS float*)(F.lds + FS);
    for (int bh = blockIdx.x; bh < BATCH * MLH; bh += F.G) {
        f32x4 Cacc[8];
#pragma unroll
        for (int i = 0; i < 8; ++i) Cacc[i] = (f32x4){0.f, 0.f, 0.f, 0.f};
        if (F.tid < 256) fs[F_NV + F.tid] = 0.f;
        if (F.tid == 0) fs[F_MISC] = 0.f;
        __syncthreads();
        mlstm_chunks(F, L, proj, gates, hmix, bh >> 2, bh & 3, 0, SEQ / 64, Cacc);
        __syncthreads();
    }
}
}

__device__ __forceinline__ int t5_bucket(int d) { if (d < 16) return d; const int v = 16 + (int)(logf((float)d * (1.f / 16.f)) / 2.0794415416798357f * 16.f); return v < 31 ? v : 31; }
__device__ __forceinline__ void n_swa(Frame& F, const LayerW& L, const float* rel_bias, const f16* proj, f16* hmix) {
    if (blockIdx.x < 32) return;
    const size_t nthr = (size_t)(F.G - 32) * NTHR;
    for (size_t it = (size_t)(blockIdx.x - 32) * NTHR + F.tid; it < (size_t)M * SWH; it += nthr) {
        const int hq = (int)(it / M); const size_t row = it % M; const int t = (int)(row % SEQ), kvh = hq >> 2;
        float q[64], o[64];
#pragma unroll
        for (int d8 = 0; d8 < 8; ++d8) { const f16x8 v = *(const f16x8*)(proj + row * NPROJ + PC_SQ + hq * 64 + d8 * 8);
#pragma unroll
            for (int e = 0; e < 8; ++e) { q[d8 * 8 + e] = (float)v[e] * 0.125f; o[d8 * 8 + e] = 0.f; } }
        float mx = L.swa_sinks[hq], l = 1.f;
        const int blk0 = (t / 128) * 128 - 128;
        int klo = t - 127; if (klo < blk0) klo = blk0; if (klo < 0) klo = 0;
        for (int kp = klo; kp <= t; ++kp) {
            const size_t krow = row - (size_t)(t - kp);
            float s = 0.f;
#pragma unroll
            for (int d8 = 0; d8 < 8; ++d8) { const f16x8 v = *(const f16x8*)(proj + krow * NPROJ + PC_SK + kvh * 64 + d8 * 8);
#pragma unroll
                for (int e = 0; e < 8; ++e) s += q[d8 * 8 + e] * (float)v[e]; }
            s += rel_bias[t5_bucket(t - kp) * SWH + hq];
            const float mn = fmaxf(mx, s), al = __expf(mx - mn), p = __expf(s - mn); mx = mn; l = l * al + p;
#pragma unroll
            for (int d8 = 0; d8 < 8; ++d8) { const f16x8 v = *(const f16x8*)(proj + krow * NPROJ + PC_SV + kvh * 64 + d8 * 8);
#pragma unroll
                for (int e = 0; e < 8; ++e) o[d8 * 8 + e] = o[d8 * 8 + e] * al + p * (float)v[e]; }
        }
        const float rl = 1.f / l;
#pragma unroll
        for (int d8 = 0; d8 < 8; ++d8) { u32x4 w; w.x = pk2h(o[d8 * 8] * rl, o[d8 * 8 + 1] * rl); w.y = pk2h(o[d8 * 8 + 2] * rl, o[d8 * 8 + 3] * rl); w.z = pk2h(o[d8 * 8 + 4] * rl, o[d8 * 8 + 5] * rl); w.w = pk2h(o[d8 * 8 + 6] * rl, o[d8 * 8 + 7] * rl);
            *(u32x4*)(hmix + row * DM + MLW + hq * 64 + d8 * 8) = w; }
    }
}
__device__ __forceinline__ void n_softmax(Frame& F, const float* S, f16* P) {
    for (size_t it = F.gw; it < (size_t)M * 4; it += F.ngw) {
        const f32x4 v = *(const f32x4*)(S + it * 256 + F.lane * 4);
        const float mx = wave_max(fmaxf(fmaxf(v.x, v.y), fmaxf(v.z, v.w)));
        const float e0 = __expf(v.x - mx), e1 = __expf(v.y - mx), e2 = __expf(v.z - mx), e3 = __expf(v.w - mx);
        const float r = 1.f / wave_sum((e0 + e1) + (e2 + e3));
        u32x2 w; w.x = pk2h(e0 * r, e1 * r); w.y = pk2h(e2 * r, e3 * r); *(u32x2*)(P + it * 256 + F.lane * 4) = w;
    }
}
__device__ __forceinline__ void n_convgelu(Frame& F, const LayerW& L, const f16* U, int r0, int nr, f16* H) {
    const size_t nthr = (size_t)F.G * NTHR, tot = (size_t)nr * DFF;
    for (size_t it = (size_t)F.vcu * NTHR + F.tid; it < tot; it += nthr) {
        const int lr = (int)(it / DFF), j = (int)(it % DFF); const int t = (r0 + lr) % SEQ;
        float g = L.ffn_conv_b[j], v = L.ffn_conv_b[DFF + j];
#pragma unroll
        for (int k = 0; k < 3; ++k) { const int tt = t - 2 + k; if (tt >= 0) { g += L.ffn_conv_w[k * DFF2 + j] * (float)U[(size_t)(lr - 2 + k) * DFF2 + j]; v += L.ffn_conv_w[k * DFF2 + DFF + j] * (float)U[(size_t)(lr - 2 + k) * DFF2 + DFF + j]; } }
        H[(size_t)(r0 + lr) * DFF + j] = (f16)(gelu_tanh(g) * v);
    }
}

struct Args { void* in[24]; float* out; unsigned char* ws; int ph_lo, ph_hi; };
__global__ void __launch_bounds__(NTHR, 2) fwd_kernel(Args args) {
    extern __shared__ __attribute__((aligned(16))) unsigned char lds[];
    Frame F;
    F.lds = (LAS unsigned char*)lds; F.MISC = (volatile LAS unsigned*)(F.lds + MISC_OFF);
    F.tid = threadIdx.x; F.lane = F.tid & 63; F.wave = __builtin_amdgcn_readfirstlane(F.tid >> 6);
    F.G = gridDim.x; { const int bx = blockIdx.x; F.vcu = (F.G % 8 == 0) ? (bx % 8) * (F.G / 8) + bx / 8 : bx; }
    F.gw = F.vcu * NWAVES + F.wave; F.ngw = F.G * NWAVES;
    F.ws = args.ws; F.ctl = (gu32*)(args.ws + WS_CTL); F.out = args.out;
    F.x_in = (const float*)args.in[0]; F.mem = (const float*)args.in[1]; F.rel_bias = (const float*)args.in[2];
    for (int u = F.tid; u < (LDS_BYTES - LDSCTL_OFF) / 4; u += NTHR) ((LAS unsigned*)(F.lds + LDSCTL_OFF))[u] = 0u;
    __syncthreads();
    const bool single = (args.ph_hi - args.ph_lo) > 1;
    XcdBarrier bar; bar.bar = (unsigned*)(F.ctl + CW_BAR); bar.x = 0; bar.st = nullptr;
    if (single) bar = xcd_barrier_post((unsigned*)(F.ctl + CW_BAR), F.MISC + 8);
    int ph = 0;
    const int lo = args.ph_lo, hi = args.ph_hi;
#define PHASE_BEGIN if (lo <= ph && ph < hi) { { int t_ = threadIdx.x; asm volatile("" : "+v"(t_)); F.tid = t_; F.lane = t_ & 63; }
#define PHASE_END   if (ph + 1 < hi) xcd_barrier(bar); } ++ph;

    f16* memb = (f16*)(F.ws + WS_MEMB); float* gates = (float*)(F.ws + WS_GATES); f16* xb = (f16*)(F.ws + WS_XB);
    f16* proj = (f16*)(F.ws + WS_BIG); float* Sf = (float*)(F.ws + WS_BIG); f16* hffn = (f16*)(F.ws + WS_BIG);
    f16* hmix = (f16*)(F.ws + WS_HMIX); f16* Pb = (f16*)(F.ws + WS_HMIX); f16* uchunk = (f16*)(F.ws + WS_HMIX);

    PHASE_BEGIN
        for (int l = 0; l < DEPTH; ++l) {
            const LayerW L = layer_w(args.in, F.ws, l);
            transpose_all(F, L.w_in, NIN, DM, (f16*)(L.wb + WL_WIN), NPROJ, [](int n) { return n < 2048 ? n : n + 8; });
            transpose_all(F, L.w_out, DM, DM, (f16*)(L.wb + WL_WOUT), DM, [](int n) { return n; });
            transpose_all(F, L.xa_wkv, 2 * DM, DM, (f16*)(L.wb + WL_WKV), 2 * DM, [](int n) { return n; });
            transpose_all(F, L.xa_wo, DM, DM, (f16*)(L.wb + WL_WO), DM, [](int n) { return n; });
            transpose_all(F, L.w_up, DFF2, DM, (f16*)(L.wb + WL_WUP), DFF2, [](int n) { return n; });
            transpose_all(F, L.w_down, DM, DFF, (f16*)(L.wb + WL_WDN), DM, [](int n) { return n; });
            convert_f16(F, L.xa_wq, (f16*)(L.wb + WL_WQN), (size_t)DM * DM);
            float* Wg = (float*)(L.wb + WL_WG);
            for (int i = F.vcu * NTHR + F.tid; i < 8 * DM; i += F.G * NTHR) { const int c = i / DM, k = i % DM; Wg[i] = L.w_in[(size_t)k * NIN + 2048 + c]; }
        }
        convert_f16(F, F.mem, memb, (size_t)2048 * DM);
        convert_f16(F, F.x_in, xb, (size_t)M * DM);
    PHASE_END

    PHASE_BEGIN
        for (int l = 0; l < DEPTH; ++l) { unsigned char* wb = F.ws + WS_W + (size_t)l * WL_SIZE;
            auto S = pg8::flat_sched(memb, DM, (const f16*)(wb + WL_WKV), DM, 8, 8, 1 << 20, 0);
            pg8::gemm_phase<pg8::EpiF16, decltype(S), false>(F.lds, pg8::Geo{DM, DM, DM}, S, pg8::EpiF16{(f16*)(wb + WL_KV), 2048, 1.f}); }
    PHASE_END
    PHASE_BEGIN
        { unsigned char* w0 = F.ws + WS_W;
          auto S1 = pg8::make_sched(256, [=](int L, pg8::Unit& u) { const int l = L >> 7, r = L & 127, z = r >> 2, pn = r & 3, b = z >> 2, h = z & 3; const unsigned char* wb = w0 + (size_t)l * WL_SIZE;
              u.pm = 0; u.pn = pn; u.a = (const char*)(wb + WL_KV) + ((size_t)b * 256 * 2048 + h * 256) * 2; u.b = (const char*)(wb + WL_WQN) + ((size_t)pn * 256 * DM + h * 256) * 2;
              u.ooff = (long)((size_t)l * (WL_SIZE / 2) + (size_t)b * DM * DM + (size_t)h * 256 * DM); });
          pg8::gemm_phase<pg8::EpiF16, decltype(S1), false>(F.lds, pg8::Geo{2048, DM, 256}, S1, pg8::EpiF16{(f16*)(w0 + WL_GT), DM, 0.0625f});
          auto S2 = pg8::make_sched(256, [=](int L, pg8::Unit& u) { const int l = L >> 7, r = L & 127, z = r >> 2, pm = r & 3, b = z >> 2, h = z & 3; const unsigned char* wb = w0 + (size_t)l * WL_SIZE;
              u.pm = pm; u.pn = 0; u.a = (const char*)(wb + WL_WO) + ((size_t)pm * 256 * DM + h * 256) * 2; u.b = (const char*)(wb + WL_KV) + ((size_t)b * 256 * 2048 + 1024 + h * 256) * 2;
              u.ooff = (long)((size_t)l * (WL_SIZE / 2) + (size_t)b * DM * DM + (size_t)h * 256); });
          pg8::gemm_phase<pg8::EpiF16, decltype(S2), false>(F.lds, pg8::Geo{DM, 2048, 256}, S2, pg8::EpiF16{(f16*)(w0 + WL_VWT), DM, 1.f}); }
    PHASE_END

    for (int l = 0; l < DEPTH; ++l) {
        const LayerW L = layer_w(args.in, F.ws, l);
        const float* xres = (l == 0) ? F.x_in : F.out;
        PHASE_BEGIN
            { auto S = pg8::flat_sched(xb, DM, (const f16*)(L.wb + WL_WIN), DM, M / 256, NPROJ / 256, 1 << 20, 0);
              pg8::gemm_phase<pg8::EpiF16, decltype(S), false>(F.lds, pg8::Geo{DM, DM, DM}, S, pg8::EpiF16{proj, NPROJ, 1.f}); }
            n_gates(F, xb, (const float*)(L.wb + WL_WG), L.ml_i_bias, L.ml_f_bias, gates);
        PHASE_END
        PHASE_BEGIN
            ml::mlstm_seq(F, L, proj, gates, hmix);
            n_swa(F, L, F.rel_bias, proj, hmix);
        PHASE_END
        PHASE_BEGIN
            { auto S = pg8::flat_sched(hmix, DM, (const f16*)(L.wb + WL_WOUT), DM, M / 256, DM / 256, 1 << 20, 0);
              pg8::gemm_phase<pg8::EpiRes, decltype(S), false>(F.lds, pg8::Geo{DM, DM, DM}, S, pg8::EpiRes{xres, F.out, DM}); }
        PHASE_END
        PHASE_BEGIN
            n_ln(F, F.out, L.ln1_g, L.ln1_b, xb);
        PHASE_END
        PHASE_BEGIN
            { auto S = pg8::flat_sched(xb, DM, (const f16*)(L.wb + WL_GT), DM, M / 256, DM / 256, SEQ / 256, (size_t)DM * DM * 2);
              pg8::gemm_phase<pg8::EpiF32, decltype(S), false>(F.lds, pg8::Geo{DM, DM, DM}, S, pg8::EpiF32{Sf, DM}); }
        PHASE_END
        PHASE_BEGIN
            n_softmax(F, Sf, Pb);
        PHASE_END
        PHASE_BEGIN
            { auto S = pg8::flat_sched(Pb, DM, (const f16*)(L.wb + WL_VWT), DM, M / 256, DM / 256, SEQ / 256, (size_t)DM * DM * 2);
              pg8::gemm_phase<pg8::EpiRes, decltype(S), false>(F.lds, pg8::Geo{DM, DM, DM}, S, pg8::EpiRes{F.out, F.out, DM}); }
        PHASE_END
        PHASE_BEGIN
            n_ln(F, F.out, L.ln2_g, L.ln2_b, xb);
        PHASE_END
        for (int c = 0; c < BATCH; ++c) {
            PHASE_BEGIN
                { auto S = pg8::flat_sched(xb + (size_t)c * SEQ * DM, DM, (const f16*)(L.wb + WL_WUP), DM, SEQ / 256, DFF2 / 256, 1 << 20, 0);
                  pg8::gemm_phase<pg8::EpiF16, decltype(S), false>(F.lds, pg8::Geo{DM, DM, DM}, S, pg8::EpiF16{uchunk, DFF2, 1.f}); }
            PHASE_END
            PHASE_BEGIN
                n_convgelu(F, L, uchunk, c * SEQ, SEQ, hffn);
            PHASE_END
        }
        PHASE_BEGIN
            { auto S = pg8::flat_sched(hffn, DFF, (const f16*)(L.wb + WL_WDN), DFF, M / 256, DM / 256, 1 << 20, 0);
              pg8::gemm_phase<pg8::EpiRes, decltype(S), false>(F.lds, pg8::Geo{DFF, DFF, DFF}, S, pg8::EpiRes{F.out, F.out, DM}); }
        PHASE_END
        PHASE_BEGIN
            n_ln(F, F.out, L.ln3_g, L.ln3_b, xb);
        PHASE_END
    }
    if (single && hi > 1) { if (__hip_atomic_load(F.ctl + CW_BAR + XB_TMO, RLX_AGENT) != 0u && F.vcu == 0 && F.tid < 64) F.out[F.tid] = __builtin_nanf(""); }
}
constexpr int NPHASES = 3 + DEPTH * (10 + 2 * BATCH);

extern "C" void kernel_launch(void* const* d_in, const int* in_sizes, int n_in, void* d_out, int out_size, void* d_ws, size_t ws_size, hipStream_t stream) {
    static int grid = 0;
    if (grid == 0) {
        if (n_in != 24 || out_size != M * DM || ws_size < WS_END) { fprintf(stderr, "kernel_launch: unexpected shapes (n_in %d out %d ws %zu)\n", n_in, out_size, ws_size); grid = -1; return; }
        int dev = 0, cus = 0;
        if (hipGetDevice(&dev) != hipSuccess || hipDeviceGetAttribute(&cus, hipDeviceAttributeMultiprocessorCount, dev) != hipSuccess) { grid = -1; return; }
        if (hipFuncSetAttribute((const void*)fwd_kernel, hipFuncAttributeMaxDynamicSharedMemorySize, LDS_BYTES) != hipSuccess) { fprintf(stderr, "hipFuncSetAttribute failed\n"); grid = -1; return; }
        (void)hipGetLastError();
        grid = cus;
    }
    if (grid < 0) return;
    hipMemsetAsync((char*)d_ws + WS_CTL, 0, CTL_ZERO_BYTES, stream);
    Args a{};
    for (int i = 0; i < 24; ++i) a.in[i] = d_in[i];
    a.out = (float*)d_out; a.ws = (unsigned char*)d_ws;
#ifndef MK_PER_PHASE
    a.ph_lo = 0; a.ph_hi = NPHASES;
    hipLaunchKernelGGL(fwd_kernel, dim3(grid), dim3(NTHR), LDS_BYTES, stream, a);
#else
    for (int p = 0; p < NPHASES; ++p) { a.ph_lo = p; a.ph_hi = p + 1; hipLaunchKernelGGL(fwd_kernel, dim3(grid), dim3(NTHR), LDS_BYTES, stream, a); }
#endif
}
```

```cpp
#include <hip/hip_runtime.h>
#include <cstdio>
#include <cstdint>

constexpr int DM = 1024, BATCH = 8, SEQ = 4096, M = BATCH * SEQ, DEPTH = 2;
constexpr int NMEM = 256, MLW = 512, MLH = 4, MLD = 128;
constexpr int SWH = 8, SWD = 64, SWKV = 2;
constexpr int NIN = 2824, NPROJ = 2816;
constexpr int DFF = 2816, DFF2 = 5632;
constexpr float ALPHA = 1.41421356237f, EPS = 1e-5f;
constexpr int PC_Q = 0, PC_K = 512, PC_V = 1024, PC_O = 1536, PC_SQ = 2048, PC_SK = 2560, PC_SV = 2688;

typedef _Float16 f16;
typedef _Float16 f16x8 __attribute__((ext_vector_type(8)));
typedef _Float16 f16x4 __attribute__((ext_vector_type(4)));
typedef _Float16 f16x2 __attribute__((ext_vector_type(2)));
typedef float f32x2 __attribute__((ext_vector_type(2)));
typedef float f32x4 __attribute__((ext_vector_type(4)));
typedef float f32x16 __attribute__((ext_vector_type(16)));
typedef unsigned u32x4 __attribute__((ext_vector_type(4)));
typedef unsigned u32x2 __attribute__((ext_vector_type(2)));

#define GAS __attribute__((address_space(1)))
#define LAS __attribute__((address_space(3)))
typedef GAS unsigned gu32;
#define RLX_AGENT __ATOMIC_RELAXED, __HIP_MEMORY_SCOPE_AGENT
#define LDS_WAIT() asm volatile("s_waitcnt lgkmcnt(0)" ::: "memory")
#define VM_WAIT() asm volatile("s_waitcnt vmcnt(0)" ::: "memory")

constexpr size_t MiB = 1u << 20;
constexpr size_t WS_CTL = 0, CTL_ZERO_BYTES = 1 * MiB;
constexpr size_t WL_WIN = 0;
constexpr size_t WL_WG = WL_WIN + (size_t)NPROJ * DM * 2;
constexpr size_t WL_WOUT = WL_WG + 8 * DM * 4;
constexpr size_t WL_WQN = WL_WOUT + (size_t)DM * DM * 2;
constexpr size_t WL_WKV = WL_WQN + (size_t)DM * DM * 2;
constexpr size_t WL_WO = WL_WKV + (size_t)2 * DM * DM * 2;
constexpr size_t WL_WUP = WL_WO + (size_t)DM * DM * 2;
constexpr size_t WL_WDN = WL_WUP + (size_t)DFF2 * DM * 2;
constexpr size_t WL_KV = WL_WDN + (size_t)DM * DFF * 2;
constexpr size_t WL_GT = WL_KV + (size_t)2048 * 2048 * 2;
constexpr size_t WL_VWT = WL_GT + (size_t)8 * DM * DM * 2;
constexpr size_t WL_SIZE = WL_VWT + (size_t)8 * DM * DM * 2;
static_assert(WL_SIZE % 256 == 0, "align");
constexpr size_t WS_W = 1 * MiB;
constexpr size_t WS_MEMB = WS_W + 2 * WL_SIZE;
constexpr size_t WS_GATES = WS_MEMB + (size_t)2048 * DM * 2;
constexpr size_t WS_XB = WS_GATES + (size_t)M * 8 * 4;
constexpr size_t WS_BIG = WS_XB + (size_t)M * DM * 2;
constexpr size_t WS_HMIX = WS_BIG + (size_t)M * NPROJ * 2;
constexpr size_t WS_AGG = WS_HMIX + (size_t)M * DM * 2;
constexpr size_t WS_END = WS_AGG + (size_t)256 * 66112;
static_assert(WS_END <= 512 * MiB, "ws");
constexpr int CW_TMO = 0, CW_CODE = 1, CW_BAR = 4096;

#define XB_TMO      128
#define XB_XCNT(j)  (256  + 64 * (j))
#define XB_XSUB(j)  (1280 + 64 * (j))
#define XB_XGEN(j)  (2304 + 64 * (j))
#define XB_TOP      3328
#define XB_TOPGEN   3392
#define XCD_BAR_WORDS 3456
#define XB_SPIN_CAP (1u << 20)
__device__ __forceinline__ unsigned xb_ld(unsigned* p)              { return __hip_atomic_load(p, __ATOMIC_RELAXED, __HIP_MEMORY_SCOPE_AGENT); }
__device__ __forceinline__ unsigned xb_add(unsigned* p, unsigned v) { return __hip_atomic_fetch_add(p, v, __ATOMIC_RELAXED, __HIP_MEMORY_SCOPE_AGENT); }
__device__ __forceinline__ unsigned xb_xcc_id() { return (unsigned)__builtin_amdgcn_s_getreg((3 << 11) | 20) & 0xFu; }
#define XB_SPIN(cond, bar) do { unsigned _sp = 0; while (cond) { __builtin_amdgcn_s_sleep(1); \
    if ((++_sp & 255u) == 0u) { if (xb_ld(&(bar)[XB_TMO])) break; if (_sp > XB_SPIN_CAP) { atomicAdd(&(bar)[XB_TMO], 1u); break; } } } } while (0)
struct XcdBarrier { unsigned* bar; unsigned x; volatile LAS unsigned* st; };
__device__ __forceinline__ XcdBarrier xcd_barrier_post(unsigned* bar, volatile LAS unsigned* st) {
    XcdBarrier b; b.bar = bar; b.x = xb_xcc_id(); b.st = st;
    if (threadIdx.x == 0) (void)xb_add(&bar[XB_XCNT(b.x)], 1u);
    return b;
}
__device__ __forceinline__ void xcd_barrier_complete(unsigned* bar, unsigned x, unsigned& nloc, unsigned& nx) {
    const unsigned G = gridDim.x * gridDim.y * gridDim.z;
    unsigned sum, cnt, mine, sp = 0u;
    for (;;) {
        sum = 0u; cnt = 0u; mine = 0u;
#pragma unroll
        for (unsigned j = 0; j < 16; ++j) { const unsigned c = xb_ld(&bar[XB_XCNT(j)]); sum += c; cnt += (c > 0u) ? 1u : 0u; mine = (j == x) ? c : mine; }
        if (sum == G) break;
        __builtin_amdgcn_s_sleep(1);
        if ((++sp & 255u) == 0u) { if (xb_ld(&bar[XB_TMO])) break; if (sp > XB_SPIN_CAP) { atomicAdd(&bar[XB_TMO], 1u); break; } }
    }
    nloc = mine > 0u ? mine : 1u; nx = cnt > 0u ? cnt : 1u;
}
__device__ __forceinline__ void xcd_barrier(const XcdBarrier& b) {
    asm volatile("s_waitcnt vmcnt(0)" ::: "memory");
    __syncthreads();
    if (threadIdx.x == 0) {
        unsigned* bar = b.bar;
        __builtin_amdgcn_s_waitcnt(0);
        unsigned nloc = b.st[0], nx = b.st[1];
        if (nloc == 0u) { xcd_barrier_complete(bar, b.x, nloc, nx); b.st[0] = nloc; b.st[1] = nx; }
        const unsigned old = xb_add(&bar[XB_XSUB(b.x)], 1u);
        const unsigned gen = old / nloc;
        if (old + 1u == (gen + 1u) * nloc) {
            __builtin_amdgcn_fence(__ATOMIC_RELEASE, "agent");
            asm volatile("s_waitcnt vmcnt(0)" ::: "memory");
            const unsigned og = xb_add(&bar[XB_TOP], 1u);
            const unsigned tg = og / nx;
            if (og + 1u == (tg + 1u) * nx) xb_add(&bar[XB_TOPGEN], 1u);
            else XB_SPIN(xb_ld(&bar[XB_TOPGEN]) == tg, bar);
            __builtin_amdgcn_fence(__ATOMIC_ACQUIRE, "agent");
            xb_add(&bar[XB_XGEN(b.x)], 1u);
            asm volatile("s_waitcnt vmcnt(0)" ::: "memory");
        } else {
            XB_SPIN(xb_ld(&bar[XB_XGEN(b.x)]) == gen, bar);
            __builtin_amdgcn_fence(__ATOMIC_ACQUIRE, "agent");
            asm volatile("s_waitcnt vmcnt(0)" ::: "memory");
        }
    }
    __syncthreads();
}

constexpr int NWAVES = 8, NTHR = 512;
constexpr int RING_BYTES = 131072, LDSCTL_OFF = RING_BYTES, MISC_OFF = LDSCTL_OFF + 320, LDS_BYTES = 147456;
struct LayerW {
    const float *w_in, *ml_conv_w, *ml_conv_b, *ml_i_bias, *ml_f_bias, *ml_norm_g, *swa_sinks, *w_out, *ln1_g, *ln1_b, *xa_wq, *xa_wkv, *xa_wo, *ln2_g, *ln2_b,
                *w_up, *ffn_conv_w, *ffn_conv_b, *w_down, *ln3_g, *ln3_b;
    unsigned char* wb;
};
struct Frame {
    LAS unsigned char* lds;
    volatile LAS unsigned* MISC;
    gu32* ctl;
    int tid, lane, wave, vcu, G, gw, ngw;
    const float *x_in, *mem, *rel_bias; float* out; unsigned char* ws;
};
__device__ __forceinline__ float wave_sum(float v) {
#pragma unroll
    for (int o = 1; o < 64; o <<= 1) v += __shfl_xor(v, o);
    return v;
}
__device__ __forceinline__ float wave_max(float v) {
#pragma unroll
    for (int o = 1; o < 64; o <<= 1) v = fmaxf(v, __shfl_xor(v, o));
    return v;
}
__device__ __forceinline__ unsigned pk2h(float lo, float hi) { f32x2 v = {lo, hi}; f16x2 h = __builtin_convertvector(v, f16x2); return __builtin_bit_cast(unsigned, h); }
__device__ __forceinline__ float siluf(float x) { return x / (1.f + __expf(-x)); }
__device__ __forceinline__ float sigmoidf_(float x) { return 1.f / (1.f + __expf(-x)); }
__device__ __forceinline__ float gelu_tanh(float x) { const float z = 1.5957691216057308f * (x + 0.044715f * x * x * x); return x / (1.f + __expf(-z)); }
__device__ __forceinline__ float logsigmoidf_(float x) { return fminf(x, 0.f) - log1pf(__expf(-fabsf(x))); }

__device__ __forceinline__ LayerW layer_w(void* const* in, unsigned char* ws, int l) {
    LayerW L;
    L.w_in = (const float*)in[3] + (size_t)l * DM * NIN;       L.ml_conv_w = (const float*)in[4] + (size_t)l * 4 * 1024; L.ml_conv_b = (const float*)in[5] + (size_t)l * 1024;
    L.ml_i_bias = (const float*)in[6] + l * 4;                  L.ml_f_bias = (const float*)in[7] + l * 4;                L.ml_norm_g = (const float*)in[8] + l * 512;
    L.swa_sinks = (const float*)in[9] + l * 8;                  L.w_out = (const float*)in[10] + (size_t)l * DM * DM;     L.ln1_g = (const float*)in[11] + l * DM; L.ln1_b = (const float*)in[12] + l * DM;
    L.xa_wq = (const float*)in[13] + (size_t)l * DM * DM;       L.xa_wkv = (const float*)in[14] + (size_t)l * DM * 2 * DM; L.xa_wo = (const float*)in[15] + (size_t)l * DM * DM;
    L.ln2_g = (const float*)in[16] + l * DM;                    L.ln2_b = (const float*)in[17] + l * DM;
    L.w_up = (const float*)in[18] + (size_t)l * DM * DFF2;      L.ffn_conv_w = (const float*)in[19] + (size_t)l * 3 * DFF2; L.ffn_conv_b = (const float*)in[20] + (size_t)l * DFF2;
    L.w_down = (const float*)in[21] + (size_t)l * DFF * DM;     L.ln3_g = (const float*)in[22] + l * DM;                  L.ln3_b = (const float*)in[23] + l * DM;
    L.wb = ws + WS_W + (size_t)l * WL_SIZE;
    return L;
}

__device__ __forceinline__ void transpose_item(const float* W, int ldw, int K, f16* WT, int ns, int nd, int k0, LAS float* scr, int lane) {
#pragma unroll 8
    for (int i = 0; i < 32; ++i) { const int kk = 2 * i + (lane >> 5); scr[kk * 33 + (lane & 31)] = W[(size_t)(k0 + kk) * ldw + ns + (lane & 31)]; }
    LDS_WAIT(); asm volatile("" ::: "memory");
    const int c = lane & 7;
#pragma unroll
    for (int j = 0; j < 4; ++j) { const int n = (lane >> 3) + 8 * j; const LAS float* s = scr + (8 * c) * 33 + n;
        u32x4 o; o.x = pk2h(s[0 * 33], s[1 * 33]); o.y = pk2h(s[2 * 33], s[3 * 33]); o.z = pk2h(s[4 * 33], s[5 * 33]); o.w = pk2h(s[6 * 33], s[7 * 33]);
        *(u32x4*)(WT + (size_t)(nd + n) * K + k0 + 8 * c) = o; }
    LDS_WAIT(); asm volatile("" ::: "memory");
}
template <class Map>
__device__ __forceinline__ void transpose_all(Frame& F, const float* W, int ldw, int K, f16* WT, int ND, Map smap) {
    LAS float* scr = (LAS float*)(F.lds + F.wave * 16384);
    const int ng = ND / 32, nk = K / 64;
    for (int it = F.gw; it < ng * nk; it += F.ngw) { const int g = it % ng, kb = it / ng; transpose_item(W, ldw, K, WT, smap(g * 32), g * 32, kb * 64, scr, F.lane); }
}
__device__ __forceinline__ void convert_f16(Frame& F, const float* src, f16* dst, size_t n) {
    const size_t nv = n / 8;
    for (size_t i = (size_t)F.gw * 64 + F.lane; i < nv; i += (size_t)F.ngw * 64) {
        const f32x4 a = ((const f32x4*)src)[2 * i], b = ((const f32x4*)src)[2 * i + 1];
        u32x4 o; o.x = pk2h(a.x, a.y); o.y = pk2h(a.z, a.w); o.z = pk2h(b.x, b.y); o.w = pk2h(b.z, b.w);
        ((u32x4*)dst)[i] = o;
    }
}

struct NG { const f16* A; long lda; const f16* Bt; long ldb; int Mb, N, K; int nb0, nb1; long sa0, sa1, sb0, sb1, so0, so1; };
template <class Epi>
__device__ __forceinline__ void ngemm(Frame& F, const NG g, const Epi& E) {
    const int tm = g.Mb / 64, tn = g.N / 64, per = tm * tn, total = per * g.nb0 * g.nb1;
    const int r32 = F.lane & 31, hi = F.lane >> 5;
    for (int t = F.gw; t < total; t += F.ngw) {
        const int z = t / per, tt = t % per, pm = tt / tn, pn = tt % tn, z0 = z / g.nb1, z1 = z % g.nb1;
        const f16* Ab = g.A + z0 * g.sa0 + z1 * g.sa1 + (long)(pm * 64 + r32) * g.lda + hi * 8;
        const f16* Bb = g.Bt + z0 * g.sb0 + z1 * g.sb1 + (long)(pn * 64 + r32) * g.ldb + hi * 8;
        f32x16 acc[2][2];
#pragma unroll
        for (int i = 0; i < 2; ++i)
#pragma unroll
            for (int j = 0; j < 2; ++j)
#pragma unroll
                for (int r = 0; r < 16; ++r) acc[i][j][r] = 0.f;
        for (int k = 0; k < g.K; k += 16) {
            const f16x8 a0 = *(const f16x8*)(Ab + k), a1 = *(const f16x8*)(Ab + 32 * g.lda + k);
            const f16x8 b0 = *(const f16x8*)(Bb + k), b1 = *(const f16x8*)(Bb + 32 * g.ldb + k);
            acc[0][0] = __builtin_amdgcn_mfma_f32_32x32x16_f16(b0, a0, acc[0][0], 0, 0, 0);
            acc[0][1] = __builtin_amdgcn_mfma_f32_32x32x16_f16(b1, a0, acc[0][1], 0, 0, 0);
            acc[1][0] = __builtin_amdgcn_mfma_f32_32x32x16_f16(b0, a1, acc[1][0], 0, 0, 0);
            acc[1][1] = __builtin_amdgcn_mfma_f32_32x32x16_f16(b1, a1, acc[1][1], 0, 0, 0);
        }
        const long ooff = z0 * g.so0 + z1 * g.so1;
#pragma unroll
        for (int i = 0; i < 2; ++i)
#pragma unroll
            for (int j = 0; j < 2; ++j)
#pragma unroll
                for (int q = 0; q < 4; ++q) {
                    const f32x4 v = {acc[i][j][4 * q], acc[i][j][4 * q + 1], acc[i][j][4 * q + 2], acc[i][j][4 * q + 3]};
                    E(ooff, pm * 64 + 32 * i + r32, pn * 64 + 32 * j + 8 * q + 4 * hi, v);
                }
    }
}
struct EpF16 { f16* O; long ldo; float scale;
    __device__ __forceinline__ void operator()(long ooff, int row, int col, f32x4 v) const { u32x2 w; w.x = pk2h(v.x * scale, v.y * scale); w.y = pk2h(v.z * scale, v.w * scale); *(u32x2*)(O + ooff + (long)row * ldo + col) = w; } };
struct EpF32 { float* O; long ldo;
    __device__ __forceinline__ void operator()(long ooff, int row, int col, f32x4 v) const { *(f32x4*)(O + ooff + (long)row * ldo + col) = v; } };
struct EpRes { const float* X; float* O; long ldo;
    __device__ __forceinline__ void operator()(long ooff, int row, int col, f32x4 v) const { const f32x4 x = *(const f32x4*)(X + ooff + (long)row * ldo + col); *(f32x4*)(O + ooff + (long)row * ldo + col) = x * ALPHA + v; } };

namespace pg8 {
constexpr int BM = 256, BK = 64, HALF = 128, HTB = HALF * BK * 2, STAGE_BYTES = 8 * HTB, NXCD = 8, WGM = 8;
__host__ __device__ __forceinline__ int lds_byte(int r, int c) { const int st = (r >> 4) * 2 + (c >> 5), rr = r & 15, cc = c & 31, ob = rr * 64 + cc * 2; return st * 1024 + (ob ^ (((ob >> 9) & 1) << 5)); }
__host__ __device__ __forceinline__ void stage_rc(int b, int& R, int& C) { const int st = b / 1024, sb = b % 1024, swz = sb ^ (((sb >> 9) & 1) << 5); R = (st >> 1) * 16 + swz / 64; C = (st & 1) * 32 + (swz % 64) / 2; }
__host__ __device__ __forceinline__ int perm32(int rho) { const int n = rho >> 4, i = rho & 15; return 8 * (i >> 2) + 4 * n + (i & 3); }
struct Unit { int pm, pn; const char* a; const char* b; long ooff; };
struct Geo { int lda, ldb, K; };
__device__ __forceinline__ void static_map(int L, int nM, int nN, int& pm, int& pn) {
    const int nwg = nM * nN; int wgid = L; { const int q = nwg / NXCD, r = nwg % NXCD, xcd = wgid % NXCD, off = wgid / NXCD; wgid = (xcd < r ? xcd * (q + 1) : r * (q + 1) + (xcd - r) * q) + off; }
    const int nig = WGM * nN, gid = wgid / nig, fm = gid * WGM, gsz = (nM - fm) < WGM ? (nM - fm) : WGM;
    pm = fm + ((wgid % nig) % gsz); pn = (wgid % nig) / gsz;
}
template <class Fn> struct FnSched { int n, G, c; Fn f;
    __device__ __forceinline__ bool next(int i, Unit& u) const { const long L = (long)i * G + c; if (L >= n) return false; f((int)L, u); return true; } };
template <class Fn> __device__ __forceinline__ FnSched<Fn> make_sched(int n, Fn f) { return FnSched<Fn>{n, (int)gridDim.x, (int)blockIdx.x, f}; }

typedef f32x4 Acc[2][2][4][2];
struct EpiF16 { static constexpr bool PERM = true; f16* O; int ldc; float sc;
    __device__ __forceinline__ void operator()(Acc& acc, const Unit& u, int wr, int wc, int fr, int fq, LAS unsigned char*, int, int) const {
        f16* base = O + u.ooff + (size_t)(u.pm * BM + wr * 64 + fr) * ldc + u.pn * BM + wc * 32 + 8 * fq;
#pragma unroll
        for (int ai = 0; ai < 2; ++ai)
#pragma unroll
            for (int m = 0; m < 4; ++m) { f16* rowp = base + (size_t)(ai * HALF + m * 16) * ldc;
#pragma unroll
                for (int bj = 0; bj < 2; ++bj) { const f32x4 v0 = acc[ai][bj][m][0] * sc, v1 = acc[ai][bj][m][1] * sc;
                    u32x4 w; w.x = pk2h(v0[0], v0[1]); w.y = pk2h(v0[2], v0[3]); w.z = pk2h(v1[0], v1[1]); w.w = pk2h(v1[2], v1[3]);
                    *(u32x4*)(rowp + bj * HALF) = w; } }
    } };
struct EpiF32 { static constexpr bool PERM = false; float* O; int ldc;
    __device__ __forceinline__ void operator()(Acc& acc, const Unit& u, int wr, int wc, int fr, int fq, LAS unsigned char*, int, int) const {
        float* base = O + u.ooff + (size_t)(u.pm * BM + wr * 64 + fr) * ldc + u.pn * BM + wc * 32 + 4 * fq;
#pragma unroll
        for (int ai = 0; ai < 2; ++ai)
#pragma unroll
            for (int m = 0; m < 4; ++m) { float* rowp = base + (size_t)(ai * HALF + m * 16) * ldc;
#pragma unroll
                for (int bj = 0; bj < 2; ++bj)
#pragma unroll
                    for (int n = 0; n < 2; ++n) *(f32x4*)(rowp + bj * HALF + n * 16) = acc[ai][bj][m][n]; }
    } };
struct EpiRes { static constexpr bool PERM = false; const float* X; float* O; int ldc;
    __device__ __forceinline__ void operator()(Acc& acc, const Unit& u, int wr, int wc, int fr, int fq, LAS unsigned char*, int, int) const {
        const size_t off0 = u.ooff + (size_t)(u.pm * BM + wr * 64 + fr) * ldc + u.pn * BM + wc * 32 + 4 * fq;
#pragma unroll
        for (int ai = 0; ai < 2; ++ai)
#pragma unroll
            for (int m = 0; m < 4; ++m) { const size_t off = off0 + (size_t)(ai * HALF + m * 16) * ldc;
#pragma unroll
                for (int bj = 0; bj < 2; ++bj)
#pragma unroll
                    for (int n = 0; n < 2; ++n) { const f32x4 x = *(const f32x4*)(X + off + bj * HALF + n * 16); *(f32x4*)(O + off + bj * HALF + n * 16) = x * ALPHA + acc[ai][bj][m][n]; } }
    } };

template <class Epi, class Sched, bool ALIGN_EPI>
__device__ __forceinline__ void gemm_phase(LAS unsigned char* lds, const Geo g, const Sched& S, const Epi& E) {
    int tid_ = threadIdx.x; asm volatile("" : "+v"(tid_));
    const int tid = tid_, wid = __builtin_amdgcn_readfirstlane(tid >> 6), lane = tid & 63, wr = wid >> 2, wc = wid & 3, fr = lane & 15, fq = lane >> 4;
    const int nt = g.K / BK;
    unsigned voffA[2], voffB[2];
#pragma unroll
    for (int i = 0; i < 2; ++i) { int R, C; stage_rc(tid * 16 + i * 8192, R, C); const int Rb = Epi::PERM ? ((R & ~31) + perm32(R & 31)) : R;
        voffA[i] = (unsigned)(R * g.lda + C) * 2u; voffB[i] = (unsigned)(Rb * g.ldb + C) * 2u; }
    const size_t kstep = (size_t)(BK * 2);
    const size_t hstepA = (size_t)HALF * g.lda * 2, hstepB = (size_t)HALF * g.ldb * 2;
    const unsigned ldsw = (unsigned)wid * 1024u;
    const int aoff = lds_byte(wr * 64 + fr, fq * 8), boff = lds_byte(wc * 32 + fr, fq * 8);
#define PG8_SA(b, h) (((b) * 2 + (h)) * HTB)
#define PG8_SB(b, h) ((4 + (b) * 2 + (h)) * HTB)
#define PG8_STAGE(bufoff, gbase, voff) do { _Pragma("unroll") for (int _i = 0; _i < 2; ++_i) \
        __builtin_amdgcn_global_load_lds((const unsigned*)((const char*)(gbase) + (voff)[_i]), (LAS unsigned*)(lds + (bufoff) + ldsw + _i * 8192), 16, 0, 0); } while (0)
#define PG8_LDA(dst, b, h) do { _Pragma("unroll") for (int m = 0; m < 4; ++m) _Pragma("unroll") for (int k = 0; k < 2; ++k) dst[m][k] = *(const LAS f16x8*)(lds + PG8_SA(b, h) + aoff + m * 2048 + k * 1024); } while (0)
#define PG8_LDB(dst, b, h) do { _Pragma("unroll") for (int n = 0; n < 2; ++n) _Pragma("unroll") for (int k = 0; k < 2; ++k) dst[n][k] = *(const LAS f16x8*)(lds + PG8_SB(b, h) + boff + n * 2048 + k * 1024); } while (0)
#define PG8_MMA(ai, bj, At, Bt) do { __builtin_amdgcn_s_setprio(1); _Pragma("unroll") for (int m = 0; m < 4; ++m) _Pragma("unroll") for (int n = 0; n < 2; ++n) _Pragma("unroll") for (int k = 0; k < 2; ++k) \
        acc[ai][bj][m][n] = __builtin_amdgcn_mfma_f32_16x16x32_f16(Bt[n][k], At[m][k], acc[ai][bj][m][n], 0, 0, 0); __builtin_amdgcn_s_setprio(0); } while (0)
#define PG8_WAIT_V(n) asm volatile("s_waitcnt vmcnt(" #n ")" ::: "memory")
#define PG8_WAIT_L(n) asm volatile("s_waitcnt lgkmcnt(" #n ")" ::: "memory")
#define PG8_BAR __builtin_amdgcn_s_barrier()
#define PG8_SCHED __builtin_amdgcn_sched_barrier(0)
    Unit cur, nxt; int ui = 0;
    if (!S.next(0, cur)) return;
    Acc acc;
#pragma unroll
    for (int a = 0; a < 2; ++a)
#pragma unroll
        for (int b = 0; b < 2; ++b)
#pragma unroll
            for (int m = 0; m < 4; ++m)
#pragma unroll
                for (int n = 0; n < 2; ++n) acc[a][b][m][n] = (f32x4){0.f, 0.f, 0.f, 0.f};
    f16x8 At[4][2], B0[2][2], B1[2][2];
    const char* cA = cur.a; const char* cB = cur.b;
    PG8_STAGE(PG8_SB(0, 0), cB, voffB); PG8_STAGE(PG8_SB(0, 1), cB + hstepB, voffB); PG8_STAGE(PG8_SA(0, 0), cA, voffA); PG8_STAGE(PG8_SA(0, 1), cA + hstepA, voffA);
    if (wr == 1) PG8_BAR;
    PG8_WAIT_V(2); PG8_BAR;
    PG8_STAGE(PG8_SB(1, 0), cB + kstep, voffB); PG8_STAGE(PG8_SA(1, 0), cA + kstep, voffA); PG8_STAGE(PG8_SB(1, 1), cB + hstepB + kstep, voffB);
    PG8_WAIT_V(6); PG8_BAR;
    for (;;) {
        const bool has_next = S.next(ui + 1, nxt);
        const char* nA = has_next ? nxt.a : cA; const char* nB = has_next ? nxt.b : cB;
        for (int t = 0; t < nt; t += 2) {
            const bool last = (t == nt - 2);
            const char* a1 = cA + (size_t)(t + 1) * kstep;
            const char* a2 = last ? nA : cA + (size_t)(t + 2) * kstep; const char* b2 = last ? nB : cB + (size_t)(t + 2) * kstep;
            const char* a3 = a2 + kstep; const char* b3 = b2 + kstep;
            PG8_LDB(B0, 0, 0); PG8_LDB(B1, 0, 1); PG8_SCHED; PG8_LDA(At, 0, 0); PG8_STAGE(PG8_SA(1, 1), a1 + hstepA, voffA);
            PG8_WAIT_V(8); PG8_WAIT_L(0); PG8_BAR; PG8_MMA(0, 0, At, B0); PG8_MMA(0, 1, At, B1); PG8_BAR; PG8_SCHED;
            PG8_LDA(At, 0, 1); PG8_STAGE(PG8_SB(0, 0), b2, voffB); PG8_STAGE(PG8_SB(0, 1), b2 + hstepB, voffB); PG8_STAGE(PG8_SA(0, 0), a2, voffA);
            PG8_WAIT_V(8); PG8_WAIT_L(0); PG8_BAR; PG8_MMA(1, 0, At, B0); PG8_MMA(1, 1, At, B1); PG8_BAR; PG8_SCHED;
            PG8_LDB(B0, 1, 0); PG8_LDB(B1, 1, 1); PG8_SCHED; PG8_LDA(At, 1, 0); PG8_STAGE(PG8_SA(0, 1), a2 + hstepA, voffA);
            PG8_WAIT_V(8); PG8_WAIT_L(0); PG8_BAR; PG8_MMA(0, 0, At, B0); PG8_MMA(0, 1, At, B1); PG8_BAR; PG8_SCHED;
            PG8_LDA(At, 1, 1); PG8_STAGE(PG8_SB(1, 0), b3, voffB); PG8_STAGE(PG8_SB(1, 1), b3 + hstepB, voffB); PG8_STAGE(PG8_SA(1, 0), a3, voffA);
            PG8_WAIT_V(8); PG8_WAIT_L(0); PG8_BAR; PG8_MMA(1, 0, At, B0); PG8_MMA(1, 1, At, B1); PG8_BAR; PG8_SCHED;
        }
        if constexpr (ALIGN_EPI) { if (wr == 0) PG8_BAR; }
        E(acc, cur, wr, wc, fr, fq, lds, wid, lane);
        if (!has_next) break;
#pragma unroll
        for (int a = 0; a < 2; ++a)
#pragma unroll
            for (int b = 0; b < 2; ++b)
#pragma unroll
                for (int m = 0; m < 4; ++m)
#pragma unroll
                    for (int n = 0; n < 2; ++n) acc[a][b][m][n] = (f32x4){0.f, 0.f, 0.f, 0.f};
        cur = nxt; cA = nA; cB = nB; ++ui;
        if constexpr (ALIGN_EPI) { if (wr == 1) PG8_BAR; }
    }
    PG8_WAIT_V(0);
    if constexpr (!ALIGN_EPI) { if (wr == 0) PG8_BAR; }
    PG8_BAR;
#undef PG8_SA
#undef PG8_SB
#undef PG8_STAGE
#undef PG8_LDA
#undef PG8_LDB
#undef PG8_MMA
#undef PG8_WAIT_V
#undef PG8_WAIT_L
#undef PG8_BAR
#undef PG8_SCHED
}
__device__ __forceinline__ auto flat_sched(const f16* A, int lda, const f16* Bt, int ldb, int nM, int nN, int tpb, size_t bstr) {
    return make_sched(nM * nN, [=](int L, Unit& u) { static_map(L, nM, nN, u.pm, u.pn); u.a = (const char*)A + (size_t)u.pm * BM * lda * 2; u.b = (const char*)Bt + (size_t)(u.pm / tpb) * bstr + (size_t)u.pn * BM * ldb * 2; u.ooff = 0; });
}
}

__device__ __forceinline__ void n_ln(Frame& F, float* X, const float* g, const float* b, f16* XB) {
    for (int m = F.gw; m < M; m += F.ngw) {
        f32x4* xr = (f32x4*)(X + (size_t)m * DM) + F.lane;
        f32x4 v[4]; float s = 0.f;
#pragma unroll
        for (int j = 0; j < 4; ++j) { v[j] = xr[64 * j]; s += (v[j].x + v[j].y) + (v[j].z + v[j].w); }
        const float mean = wave_sum(s) * (1.f / DM); float s2 = 0.f;
#pragma unroll
        for (int j = 0; j < 4; ++j) { v[j] = v[j] - mean; s2 += (v[j].x * v[j].x + v[j].y * v[j].y) + (v[j].z * v[j].z + v[j].w * v[j].w); }
        const float rstd = 1.f / sqrtf(wave_sum(s2) * (1.f / DM) + EPS);
        u32x2* o8 = (u32x2*)(XB + (size_t)m * DM) + F.lane;
#pragma unroll
        for (int j = 0; j < 4; ++j) { const f32x4 gg = ((const f32x4*)g)[F.lane + 64 * j], bb = ((const f32x4*)b)[F.lane + 64 * j];
            const f32x4 o = v[j] * rstd * gg + bb; xr[64 * j] = o; u32x2 w; w.x = pk2h(o.x, o.y); w.y = pk2h(o.z, o.w); o8[64 * j] = w; }
    }
}
__device__ __forceinline__ void n_gates(Frame& F, const f16* XB, const float* Wg, const float* ib, const float* fb, float* gates) {
    for (int m = F.gw; m < M; m += F.ngw) {
        float xs[16];
#pragma unroll
        for (int j = 0; j < 2; ++j) { const f16x8 xv = *(const f16x8*)(XB + (size_t)m * DM + j * 512 + F.lane * 8);
#pragma unroll
            for (int e = 0; e < 8; ++e) xs[j * 8 + e] = (float)xv[e]; }
        float acc[8];
#pragma unroll
        for (int c = 0; c < 8; ++c) { float a = 0.f;
#pragma unroll
            for (int j = 0; j < 2; ++j)
#pragma unroll
                for (int e = 0; e < 8; ++e) a += xs[j * 8 + e] * Wg[c * DM + j * 512 + F.lane * 8 + e];
            acc[c] = wave_sum(a); }
        if (F.lane < 8) { float v = 0.f;
#pragma unroll
            for (int c = 0; c < 8; ++c) if (F.lane == c) v = acc[c];
            v += (F.lane < 4) ? ib[F.lane] : fb[F.lane - 4]; gates[(size_t)m * 8 + F.lane] = v; }
    }
}
__device__ __forceinline__ void n_mlstm(Frame& F, const LayerW& L, const f16* proj, const float* gates, f16* hmix) {
    LAS float* sq = (LAS float*)F.lds; LAS float* sk = sq + 128; LAS float* sv = sk + 128; LAS float* part = sv + 128; LAS float* red = part + 512;
    const int tid = F.tid, e = tid & 127, dq = tid >> 7;
    for (int bh = F.vcu; bh < BATCH * MLH; bh += F.G) {
        const int b = bh / MLH, h = bh % MLH;
        float c[32]; float nn = 0.f, mst = 0.f;
#pragma unroll
        for (int i = 0; i < 32; ++i) c[i] = 0.f;
        float cw[4], cb = 0.f; int ccol = 0;
        if (tid < 256) { const int which = tid >> 7, d = tid & 127; ccol = which * 512 + h * 128 + d; cb = L.ml_conv_b[ccol];
#pragma unroll
            for (int j = 0; j < 4; ++j) cw[j] = L.ml_conv_w[j * 1024 + ccol]; }
        const float ng = (tid < 128) ? L.ml_norm_g[h * 128 + e] : 0.f;
        for (int t = 0; t < SEQ; ++t) {
            const size_t row = (size_t)b * SEQ + t;
            if (tid < 256) { float a = cb;
#pragma unroll
                for (int j = 0; j < 4; ++j) { const int tt = t - 3 + j; if (tt >= 0) a += cw[j] * (float)proj[(row - 3 + j) * NPROJ + ccol]; }
                a = siluf(a); if (tid >= 128) { a *= 0.08838834764831845f; sk[tid & 127] = a; } else sq[tid] = a;
            } else if (tid < 384) { sv[tid - 256] = (float)proj[row * NPROJ + PC_V + h * 128 + (tid - 256)]; }
            const float ig = gates[row * 8 + h], lf = logsigmoidf_(gates[row * 8 + 4 + h]);
            const float mnew = fmaxf(lf + mst, ig), fg = __expf(lf + mst - mnew), ii = __expf(ig - mnew); mst = mnew;
            __syncthreads();
            const float ve = sv[e] * ii; float p = 0.f;
#pragma unroll
            for (int i = 0; i < 32; ++i) { const int d = 32 * dq + i; c[i] = fg * c[i] + sk[d] * ve; p += sq[d] * c[i]; }
            part[dq * 128 + e] = p;
            if (tid < 128) { nn = fg * nn + ii * sk[tid]; const float dp = wave_sum(sq[tid] * nn); if (F.lane == 0) red[F.wave] = dp; }
            __syncthreads();
            float hv = 0.f;
            if (tid < 128) { const float num = (part[e] + part[128 + e]) + (part[256 + e] + part[384 + e]); const float den = red[0] + red[1];
                hv = num / fmaxf(fabsf(den), __expf(-mst)); const float s1 = wave_sum(hv); if (F.lane == 0) red[4 + F.wave] = s1; }
            __syncthreads();
            float dv = 0.f;
            if (tid < 128) { const float mu = (red[4] + red[5]) * (1.f / 128.f); dv = hv - mu; const float s2 = wave_sum(dv * dv); if (F.lane == 0) red[8 + F.wave] = s2; }
            __syncthreads();
            if (tid < 128) { const float var = (red[8] + red[9]) * (1.f / 128.f); const float hn = dv * rsqrtf(var + EPS) * ng;
                const float og = sigmoidf_((float)proj[row * NPROJ + PC_O + h * 128 + e]); hmix[row * DM + h * 128 + e] = (f16)(og * hn); }
        }
        __syncthreads();
    }
}
namespace ml {
typedef short v4i16 __attribute__((ext_vector_type(4)));
constexpr int RS = 272, SRS = 144;
constexpr int QS = 0, KS = 64 * RS, VS = 2 * 64 * RS, SS = 3 * 64 * RS, FS = SS + 64 * SRS;
constexpr int F_BC = 0, F_U = 64, F_MT = 128, F_WINT = 192, F_WK = 256, F_DEN = 320, F_NV = 384  , F_STP = 640  , F_STF = 1664  , F_MISC = 1792, F_END = 1808;
static_assert(FS % 16 == 0 && FS + F_END * 4 <= RING_BYTES, "mlstm lds");
__device__ __forceinline__ f16x4 tr4(LAS unsigned char* p) { return __builtin_bit_cast(f16x4, __builtin_amdgcn_ds_read_tr16_b64_v4i16((LAS v4i16*)p)); }
__device__ __forceinline__ f16x8 cat8(f16x4 a, f16x4 b) { return (f16x8){a[0], a[1], a[2], a[3], b[0], b[1], b[2], b[3]}; }
__device__ __forceinline__ float sum16(float v) { v += __shfl_xor(v, 1); v += __shfl_xor(v, 2); v += __shfl_xor(v, 4); v += __shfl_xor(v, 8); return v; }
__device__ __forceinline__ float sum8(float v) { v += __shfl_xor(v, 1); v += __shfl_xor(v, 2); v += __shfl_xor(v, 4); return v; }

template <bool AGG>
__device__ __forceinline__ int mlstm_chunks(Frame& F, const LayerW& L, const f16* proj, const float* gates, f16* hmix, int b, int h, int c0, int nch, f32x4 (&Cacc)[8]) {
    LAS unsigned char* lds = F.lds; LAS float* fs = (LAS float*)(lds + FS);
    const int tid = F.tid, lane = F.lane, w = F.wave, i16 = lane & 15, g = lane >> 4;
    const int cp = tid & 127, rg = tid >> 7, c2 = 2 * cp, which = c2 >> 7, dcol = c2 & 127, ccol = which * 512 + h * 128 + dcol;
    float cw0[4], cw1[4]; const float cb0 = L.ml_conv_b[ccol], cb1 = L.ml_conv_b[ccol + 1];
#pragma unroll
    for (int j = 0; j < 4; ++j) { cw0[j] = L.ml_conv_w[j * 1024 + ccol]; cw1[j] = L.ml_conv_w[j * 1024 + ccol + 1]; }
    const float kscale = which ? 0.08838834764831845f : 1.f;
    const int ecol = h * 128 + 16 * w + i16; const float ng = L.ml_norm_g[ecol];
    int nb = 0;
    for (int c = c0; c < c0 + nch; ++c) {
        const size_t row0 = (size_t)b * SEQ + (size_t)c * 64;
        const float m_prev = fs[F_MISC];
        if (!AGG || which) { const f16* src = proj + row0 * NPROJ + ccol; float p0[3], p1[3];
#pragma unroll
          for (int rr = 0; rr < 3; ++rr) { const int tl = 16 * rg - 3 + rr; if (c * 64 + tl >= 0) { const f16x2 v = *(const f16x2*)(src + (long)tl * NPROJ); p0[rr] = (float)v[0]; p1[rr] = (float)v[1]; } else { p0[rr] = 0.f; p1[rr] = 0.f; } }
          LAS unsigned char* dst = lds + (which ? KS : QS) + dcol * 2;
#pragma unroll
          for (int r = 0; r < 16; ++r) { const f16x2 v = *(const f16x2*)(src + (long)(16 * rg + r) * NPROJ); const float x0 = (float)v[0], x1 = (float)v[1];
              const float a0 = cb0 + cw0[0] * p0[0] + cw0[1] * p0[1] + cw0[2] * p0[2] + cw0[3] * x0, a1 = cb1 + cw1[0] * p1[0] + cw1[1] * p1[1] + cw1[2] * p1[2] + cw1[3] * x1;
              p0[0] = p0[1]; p0[1] = p0[2]; p0[2] = x0; p1[0] = p1[1]; p1[1] = p1[2]; p1[2] = x1;
              *(LAS unsigned*)(dst + (16 * rg + r) * RS) = pk2h(siluf(a0) * kscale, siluf(a1) * kscale); } }
        { const int r = tid >> 3, sg = tid & 7; const f16* vs = proj + (row0 + r) * NPROJ + PC_V + h * 128 + sg * 16;
          const u32x4 v0 = *(const u32x4*)vs, v1 = *(const u32x4*)(vs + 8); *(LAS u32x4*)(lds + VS + r * RS + sg * 32) = v0; *(LAS u32x4*)(lds + VS + r * RS + sg * 32 + 16) = v1; }
        if (w == 0) {
            const float ig = gates[(row0 + lane) * 8 + h], lf = logsigmoidf_(gates[(row0 + lane) * 8 + 4 + h]);
            float bc = lf;
#pragma unroll
            for (int o = 1; o < 64; o <<= 1) { const float t = __shfl_up(bc, o); if (lane >= o) bc += t; }
            const float u = ig - bc; float cm = u;
#pragma unroll
            for (int o = 1; o < 64; o <<= 1) { const float t = __shfl_up(cm, o); if (lane >= o) cm = fmaxf(cm, t); }
            const float Mt = fmaxf(m_prev, cm), wint = __expf(m_prev - Mt), gtot = __shfl(bc, 63), a = gtot + u, amax = wave_max(a);
            const float m_new = fmaxf(gtot + m_prev, amax), decay = __expf(gtot + m_prev - m_new), wk = __expf(a - m_new);
            fs[F_BC + lane] = bc; fs[F_U + lane] = u; fs[F_MT + lane] = Mt; fs[F_WINT + lane] = wint; fs[F_WK + lane] = wk;
            if (lane == 0) { fs[F_MISC + 2] = m_new; fs[F_MISC + 1] = decay; if (AGG) fs[F_MISC + 3] += gtot; }
        }
        __syncthreads();
        f32x4 num[4]; f16x8 Vf[2];
        if constexpr (!AGG) {
        { const int tt = w >> 1, st0 = 2 * (w & 1);
#pragma unroll
          for (int j = 0; j < 2; ++j) { const int st = st0 + j; f32x4 acc = {0.f, 0.f, 0.f, 0.f};
              if (st <= tt) {
#pragma unroll
                  for (int kd = 0; kd < 4; ++kd) { const f16x8 a = *(const LAS f16x8*)(lds + QS + (16 * tt + i16) * RS + (32 * kd + 8 * g) * 2), bb = *(const LAS f16x8*)(lds + KS + (16 * st + i16) * RS + (32 * kd + 8 * g) * 2);
                      acc = __builtin_amdgcn_mfma_f32_16x16x32_f16(a, bb, acc, 0, 0, 0); }
                  const int sc = 16 * st + i16; const float us = fs[F_U + sc];
#pragma unroll
                  for (int r = 0; r < 4; ++r) { const int t = 16 * tt + 4 * g + r; acc[r] = (sc <= t) ? acc[r] * __expf(us - fs[F_MT + t]) : 0.f; }
              }
#pragma unroll
              for (int r = 0; r < 4; ++r) *(LAS f16*)(lds + SS + (16 * tt + 4 * g + r) * SRS + (16 * st + i16) * 2) = (f16)acc[r]; } }
        __syncthreads();
        { f16x8 Cf[4];
#pragma unroll
          for (int i2 = 0; i2 < 4; ++i2) { const f32x4 x = Cacc[2 * i2], y = Cacc[2 * i2 + 1]; Cf[i2] = (f16x8){(f16)x[0], (f16)x[1], (f16)x[2], (f16)x[3], (f16)y[0], (f16)y[1], (f16)y[2], (f16)y[3]}; }
#pragma unroll
          for (int tt = 0; tt < 4; ++tt) { f32x4 acc = {0.f, 0.f, 0.f, 0.f};
#pragma unroll
              for (int i2 = 0; i2 < 4; ++i2) { const LAS unsigned char* qp = lds + QS + (16 * tt + i16) * RS + (32 * i2 + 4 * g) * 2;
                  acc = __builtin_amdgcn_mfma_f32_16x16x32_f16(cat8(*(const LAS f16x4*)qp, *(const LAS f16x4*)(qp + 32)), Cf[i2], acc, 0, 0, 0); }
#pragma unroll
              for (int r = 0; r < 4; ++r) acc[r] *= fs[F_WINT + 16 * tt + 4 * g + r];
              num[tt] = acc; } }
        }
#pragma unroll
        for (int ks = 0; ks < 2; ++ks) { LAS unsigned char* vp = lds + VS + (32 * ks + 8 * g + (i16 >> 2)) * RS + (16 * w + 4 * (i16 & 3)) * 2; Vf[ks] = cat8(tr4(vp), tr4(vp + 4 * RS)); }
        if constexpr (!AGG) {
#pragma unroll
        for (int tt = 0; tt < 4; ++tt)
#pragma unroll
            for (int ks = 0; ks < 2; ++ks) if (32 * ks <= 16 * tt + 15) { const f16x8 a = *(const LAS f16x8*)(lds + SS + (16 * tt + i16) * SRS + (32 * ks + 8 * g) * 2); num[tt] = __builtin_amdgcn_mfma_f32_16x16x32_f16(a, Vf[ks], num[tt], 0, 0, 0); }
        { const int t = 8 * w + (lane >> 3), part = lane & 7; const LAS unsigned char* qp = lds + QS + t * RS + part * 32; const LAS float* np_ = fs + F_NV + nb * 128 + part * 16;
          const f16x8 q0 = *(const LAS f16x8*)qp, q1 = *(const LAS f16x8*)(qp + 16); float dq = 0.f;
#pragma unroll
          for (int e = 0; e < 8; ++e) dq += (float)q0[e] * np_[e] + (float)q1[e] * np_[8 + e];
          const f16x8 sv = *(const LAS f16x8*)(lds + SS + t * SRS + part * 16); float rs = 0.f;
#pragma unroll
          for (int e = 0; e < 8; ++e) rs += (float)sv[e];
          dq = sum8(dq); rs = sum8(rs);
          if (part == 0) fs[F_DEN + t] = fs[F_WINT + t] * dq + rs; }
        __syncthreads();
        }
        { const float decay = fs[F_MISC + 1]; f16x8 wk8[2];
#pragma unroll
          for (int ks = 0; ks < 2; ++ks) { const f32x4 x = *(const LAS f32x4*)(fs + F_WK + 32 * ks + 8 * g), y = *(const LAS f32x4*)(fs + F_WK + 32 * ks + 8 * g + 4);
              wk8[ks] = (f16x8){(f16)x[0], (f16)x[1], (f16)x[2], (f16)x[3], (f16)y[0], (f16)y[1], (f16)y[2], (f16)y[3]}; }
#pragma unroll
          for (int dd = 0; dd < 8; ++dd) { f32x4 acc = Cacc[dd] * decay;
#pragma unroll
              for (int ks = 0; ks < 2; ++ks) { LAS unsigned char* kp = lds + KS + (32 * ks + 8 * g + (i16 >> 2)) * RS + (16 * dd + 4 * (i16 & 3)) * 2;
                  const f16x8 a = cat8(tr4(kp), tr4(kp + 4 * RS)) * wk8[ks]; acc = __builtin_amdgcn_mfma_f32_16x16x32_f16(a, Vf[ks], acc, 0, 0, 0); }
              Cacc[dd] = acc; }
          const int d = 16 * w + i16; float pn = 0.f;
#pragma unroll
          for (int ss = 0; ss < 16; ++ss) pn += fs[F_WK + 16 * g + ss] * (float)*(const LAS f16*)(lds + KS + (16 * g + ss) * RS + d * 2);
          pn += __shfl_xor(pn, 16); pn += __shfl_xor(pn, 32);
          if (g == 0) fs[F_NV + (nb ^ 1) * 128 + d] = decay * fs[F_NV + nb * 128 + d] + pn; }
        if constexpr (AGG) {
            if (tid == 0) fs[F_MISC] = fs[F_MISC + 2];
            __syncthreads();
        } else {
#pragma unroll
        for (int tt = 0; tt < 4; ++tt)
#pragma unroll
            for (int r = 0; r < 4; ++r) { const int t = 16 * tt + 4 * g + r; const float den = fs[F_DEN + t], mt = fs[F_BC + t] + fs[F_MT + t];
                const float hv = num[tt][r] / fmaxf(fabsf(den), __expf(-mt)); num[tt][r] = hv;
                const float s1 = sum16(hv), s2 = sum16(hv * hv); if (i16 == 0) *(LAS f32x2*)(fs + F_STP + (w * 64 + t) * 2) = (f32x2){s1, s2}; }
        __syncthreads();
        { const int t = 8 * w + (lane >> 3), part = lane & 7; const f32x2 p = *(const LAS f32x2*)(fs + F_STP + (part * 64 + t) * 2);
          const float s1 = sum8(p.x), s2 = sum8(p.y), mean = s1 * (1.f / 128.f), var = fmaxf(s2 * (1.f / 128.f) - mean * mean, 0.f);
          if (part == 0) *(LAS f32x2*)(fs + F_STF + t * 2) = (f32x2){mean, rsqrtf(var + EPS)};
          if (tid == 0) fs[F_MISC] = fs[F_MISC + 2]; }
        __syncthreads();
#pragma unroll
        for (int tt = 0; tt < 4; ++tt)
#pragma unroll
            for (int r = 0; r < 4; ++r) { const int t = 16 * tt + 4 * g + r; const f32x2 st = *(const LAS f32x2*)(fs + F_STF + t * 2);
                const float og = sigmoidf_((float)proj[(row0 + t) * NPROJ + PC_O + ecol]);
                hmix[(row0 + t) * DM + ecol] = (f16)((num[tt][r] - st.x) * st.y * ng * og); }
        }
        nb ^= 1;
    }
    return nb;
}
constexpr int NRUN = 8, CPR = 64 / NRUN;
constexpr size_t AGG_C = 0, AGG_N = 65536, AGG_S = 65536 + 512, AGG_STRIDE = 65536 + 512 + 64;
__device__ __forceinline__ void mlstm_agg(Frame& F, const LayerW& L, const f16* proj, const float* gates, unsigned char* agg) {
    LAS float* fs = (LAS float*)(F.lds + FS);
    for (int it = blockIdx.x; it < BATCH * MLH * NRUN; it += F.G) {
        const int bh = it / NRUN, r = it % NRUN;
        f32x4 Cacc[8];
#pragma unroll
        for (int i = 0; i < 8; ++i) Cacc[i] = (f32x4){0.f, 0.f, 0.f, 0.f};
        if (F.tid < 256) fs[F_NV + F.tid] = 0.f;
        if (F.tid == 0) { fs[F_MISC] = -1e30f; fs[F_MISC + 3] = 0.f; }
        __syncthreads();
        const int nb = mlstm_chunks<true>(F, L, proj, gates, nullptr, bh >> 2, bh & 3, r * CPR, CPR, Cacc);
        unsigned char* rec = agg + (size_t)it * AGG_STRIDE;
#pragma unroll
        for (int dd = 0; dd < 8; ++dd) *(f32x4*)(rec + AGG_C + ((size_t)(F.wave * 8 + dd) * 64 + F.lane) * 16) = Cacc[dd];
        if (F.tid < 128) ((float*)(rec + AGG_N))[F.tid] = fs[F_NV + nb * 128 + F.tid];
        if (F.tid == 0) { ((float*)(rec + AGG_S))[0] = fs[F_MISC + 3]; ((float*)(rec + AGG_S))[1] = fs[F_MISC]; }
        __syncthreads();
    }
}
__device__ __forceinline__ void mlstm_out(Frame& F, const LayerW& L, const f16* proj, const float* gates, f16* hmix, const unsigned char* agg) {
    LAS float* fs = (LAS float*)(F.lds + FS);
    for (int it = blockIdx.x; it < BATCH * MLH * NRUN; it += F.G) {
        const int bh = it / NRUN, r = it % NRUN;
        f32x4 Cacc[8];
#pragma unroll
        for (int i = 0; i < 8; ++i) Cacc[i] = (f32x4){0.f, 0.f, 0.f, 0.f};
        float nn = 0.f, m = 0.f;
        for (int rr = 0; rr < r; ++rr) {
            const unsigned char* rec = agg + (size_t)(bh * NRUN + rr) * AGG_STRIDE;
            const float G = ((const float*)(rec + AGG_S))[0], mr = ((const float*)(rec + AGG_S))[1];
            const float m2 = fmaxf(G + m, mr), fa = __expf(G + m - m2), fb = __expf(mr - m2); m = m2;
#pragma unroll
            for (int dd = 0; dd < 8; ++dd) Cacc[dd] = Cacc[dd] * fa + *(const f32x4*)(rec + AGG_C + ((size_t)(F.wave * 8 + dd) * 64 + F.lane) * 16) * fb;
            if (F.tid < 128) nn = nn * fa + ((const float*)(rec + AGG_N))[F.tid] * fb;
        }
        if (F.tid < 128) { fs[F_NV + F.tid] = nn; fs[F_NV + 128 + F.tid] = 0.f; }
        if (F.tid == 0) fs[F_MISC] = m;
        __syncthreads();
        mlstm_chunks<false>(F, L, proj, gates, hmix, bh >> 2, bh & 3, r * CPR, CPR, Cacc);
        __syncthreads();
    }
}
}

__device__ __forceinline__ int t5_bucket(int d) { if (d < 16) return d; const int v = 16 + (int)(logf((float)d * (1.f / 16.f)) / 2.0794415416798357f * 16.f); return v < 31 ? v : 31; }
namespace sw {
constexpr int KRS = 144;
constexpr int KS = 0, VS = 256 * KRS, BT = 2 * 256 * KRS, SW_END = BT + 8 * 128 * 4;
static_assert(SW_END <= RING_BYTES, "swa lds");
__device__ __forceinline__ int crow(int r, int hi) { return (r & 3) + 8 * (r >> 2) + 4 * hi; }
__device__ __forceinline__ void swa_phase(Frame& F, const LayerW& L, const float* rel_bias, const f16* proj, f16* hmix, int first, int stride) {
    LAS unsigned char* lds = F.lds; LAS float* bt = (LAS float*)(lds + BT);
    const int tid = F.tid, lane = F.lane, w = F.wave, r32 = lane & 31, hi = lane >> 5, i16 = lane & 15, gi = lane >> 4;
    for (int i = tid; i < 1024; i += NTHR) bt[i] = rel_bias[t5_bucket(i & 127) * SWH + (i >> 7)];
    __syncthreads();
    for (int u = first; u < BATCH * 32 * SWKV; u += stride) {
        const int b = u >> 6, n = (u >> 1) & 31, kvh = u & 1; const size_t rowblk = (size_t)b * SEQ + (size_t)n * 128;
        for (int i = tid; i < 256 * 8; i += NTHR) { const int c = i >> 3, seg = i & 7; u32x4 kv = {0u, 0u, 0u, 0u}, vv = {0u, 0u, 0u, 0u};
            if (n > 0 || c >= 128) { const f16* src = proj + (rowblk + c - 128) * NPROJ + kvh * 64 + seg * 8; kv = *(const u32x4*)(src + PC_SK); vv = *(const u32x4*)(src + PC_SV); }
            *(LAS u32x4*)(lds + KS + c * KRS + seg * 16) = kv; *(LAS u32x4*)(lds + VS + c * KRS + seg * 16) = vv; }
        const int g4 = w >> 1, rh = w & 1, hq = kvh * 4 + g4; const float sink = L.swa_sinks[hq];
        __syncthreads();
#pragma unroll 1
        for (int qbi = 0; qbi < 2; ++qbi) {
            const int r0 = 64 * rh + 32 * qbi, kb0 = 2 * rh + qbi, r = r0 + r32;
            f16x8 qf[4];
#pragma unroll
            for (int ks = 0; ks < 4; ++ks) qf[ks] = *(const f16x8*)(proj + (rowblk + r) * NPROJ + PC_SQ + hq * 64 + 16 * ks + 8 * hi);
            f32x16 S[5];
#pragma unroll
            for (int j = 0; j < 5; ++j) {
#pragma unroll
                for (int e = 0; e < 16; ++e) S[j][e] = 0.f;
#pragma unroll
                for (int ks = 0; ks < 4; ++ks) { const f16x8 a = *(const LAS f16x8*)(lds + KS + (32 * (kb0 + j) + r32) * KRS + (16 * ks + 8 * hi) * 2); S[j] = __builtin_amdgcn_mfma_f32_32x32x16_f16(a, qf[ks], S[j], 0, 0, 0); }
            }
            float mx = sink;
#pragma unroll
            for (int j = 0; j < 5; ++j)
#pragma unroll
                for (int e = 0; e < 16; ++e) { const int c = 32 * (kb0 + j) + crow(e, hi), dist = 128 + r - c; const bool valid = (dist >= 0) && (dist < 128) && (n > 0 || c >= 128);
                    const float sv = valid ? S[j][e] * 0.125f + bt[hq * 128 + (dist & 127)] : -1e30f; S[j][e] = sv; mx = fmaxf(mx, sv); }
            mx = fmaxf(mx, __shfl_xor(mx, 32));
            float sum = 0.f;
#pragma unroll
            for (int j = 0; j < 5; ++j)
#pragma unroll
                for (int e = 0; e < 16; ++e) { const float p = __expf(S[j][e] - mx); S[j][e] = p; sum += p; }
            sum += __shfl_xor(sum, 32); sum += __expf(sink - mx);
            const float rl = 1.f / sum;
            f32x16 O[2];
#pragma unroll
            for (int dt = 0; dt < 2; ++dt)
#pragma unroll
                for (int e = 0; e < 16; ++e) O[dt][e] = 0.f;
#pragma unroll
            for (int j = 0; j < 5; ++j)
#pragma unroll
                for (int s2 = 0; s2 < 2; ++s2) { const f16x8 bp = (f16x8){(f16)S[j][8 * s2], (f16)S[j][8 * s2 + 1], (f16)S[j][8 * s2 + 2], (f16)S[j][8 * s2 + 3], (f16)S[j][8 * s2 + 4], (f16)S[j][8 * s2 + 5], (f16)S[j][8 * s2 + 6], (f16)S[j][8 * s2 + 7]};
#pragma unroll
                    for (int dt = 0; dt < 2; ++dt) { LAS unsigned char* vp = lds + VS + (32 * (kb0 + j) + 16 * s2 + 4 * hi + (i16 >> 2)) * KRS + (32 * dt + 16 * (gi & 1) + 4 * (i16 & 3)) * 2;
                        O[dt] = __builtin_amdgcn_mfma_f32_32x32x16_f16(ml::cat8(ml::tr4(vp), ml::tr4(vp + 8 * KRS)), bp, O[dt], 0, 0, 0); } }
            f16* orow = hmix + (rowblk + r) * DM + MLW + hq * 64;
#pragma unroll
            for (int dt = 0; dt < 2; ++dt)
#pragma unroll
                for (int q4 = 0; q4 < 4; ++q4) { u32x2 o; o.x = pk2h(O[dt][4 * q4] * rl, O[dt][4 * q4 + 1] * rl); o.y = pk2h(O[dt][4 * q4 + 2] * rl, O[dt][4 * q4 + 3] * rl); *(u32x2*)(orow + 32 * dt + 8 * q4 + 4 * hi) = o; }
        }
        __syncthreads();
    }
}
}

__device__ __forceinline__ void n_swa(Frame& F, const LayerW& L, const float* rel_bias, const f16* proj, f16* hmix) {
    if (blockIdx.x < 32) return;
    const size_t nthr = (size_t)(F.G - 32) * NTHR;
    for (size_t it = (size_t)(blockIdx.x - 32) * NTHR + F.tid; it < (size_t)M * SWH; it += nthr) {
        const int hq = (int)(it / M); const size_t row = it % M; const int t = (int)(row % SEQ), kvh = hq >> 2;
        float q[64], o[64];
#pragma unroll
        for (int d8 = 0; d8 < 8; ++d8) { const f16x8 v = *(const f16x8*)(proj + row * NPROJ + PC_SQ + hq * 64 + d8 * 8);
#pragma unroll
            for (int e = 0; e < 8; ++e) { q[d8 * 8 + e] = (float)v[e] * 0.125f; o[d8 * 8 + e] = 0.f; } }
        float mx = L.swa_sinks[hq], l = 1.f;
        const int blk0 = (t / 128) * 128 - 128;
        int klo = t - 127; if (klo < blk0) klo = blk0; if (klo < 0) klo = 0;
        for (int kp = klo; kp <= t; ++kp) {
            const size_t krow = row - (size_t)(t - kp);
            float s = 0.f;
#pragma unroll
            for (int d8 = 0; d8 < 8; ++d8) { const f16x8 v = *(const f16x8*)(proj + krow * NPROJ + PC_SK + kvh * 64 + d8 * 8);
#pragma unroll
                for (int e = 0; e < 8; ++e) s += q[d8 * 8 + e] * (float)v[e]; }
            s += rel_bias[t5_bucket(t - kp) * SWH + hq];
            const float mn = fmaxf(mx, s), al = __expf(mx - mn), p = __expf(s - mn); mx = mn; l = l * al + p;
#pragma unroll
            for (int d8 = 0; d8 < 8; ++d8) { const f16x8 v = *(const f16x8*)(proj + krow * NPROJ + PC_SV + kvh * 64 + d8 * 8);
#pragma unroll
                for (int e = 0; e < 8; ++e) o[d8 * 8 + e] = o[d8 * 8 + e] * al + p * (float)v[e]; }
        }
        const float rl = 1.f / l;
#pragma unroll
        for (int d8 = 0; d8 < 8; ++d8) { u32x4 w; w.x = pk2h(o[d8 * 8] * rl, o[d8 * 8 + 1] * rl); w.y = pk2h(o[d8 * 8 + 2] * rl, o[d8 * 8 + 3] * rl); w.z = pk2h(o[d8 * 8 + 4] * rl, o[d8 * 8 + 5] * rl); w.w = pk2h(o[d8 * 8 + 6] * rl, o[d8 * 8 + 7] * rl);
            *(u32x4*)(hmix + row * DM + MLW + hq * 64 + d8 * 8) = w; }
    }
}
__device__ __forceinline__ void n_softmax(Frame& F, const float* S, f16* P) {
    for (size_t it = F.gw; it < (size_t)M * 4; it += F.ngw) {
        const f32x4 v = *(const f32x4*)(S + it * 256 + F.lane * 4);
        const float mx = wave_max(fmaxf(fmaxf(v.x, v.y), fmaxf(v.z, v.w)));
        const float e0 = __expf(v.x - mx), e1 = __expf(v.y - mx), e2 = __expf(v.z - mx), e3 = __expf(v.w - mx);
        const float r = 1.f / wave_sum((e0 + e1) + (e2 + e3));
        u32x2 w; w.x = pk2h(e0 * r, e1 * r); w.y = pk2h(e2 * r, e3 * r); *(u32x2*)(P + it * 256 + F.lane * 4) = w;
    }
}
__device__ __forceinline__ void n_convgelu(Frame& F, const LayerW& L, const f16* U, int r0, int nr, f16* H) {
    const size_t nthr = (size_t)F.G * NTHR, tot = (size_t)nr * DFF;
    for (size_t it = (size_t)F.vcu * NTHR + F.tid; it < tot; it += nthr) {
        const int lr = (int)(it / DFF), j = (int)(it % DFF); const int t = (r0 + lr) % SEQ;
        float g = L.ffn_conv_b[j], v = L.ffn_conv_b[DFF + j];
#pragma unroll
        for (int k = 0; k < 3; ++k) { const int tt = t - 2 + k; if (tt >= 0) { g += L.ffn_conv_w[k * DFF2 + j] * (float)U[(size_t)(lr - 2 + k) * DFF2 + j]; v += L.ffn_conv_w[k * DFF2 + DFF + j] * (float)U[(size_t)(lr - 2 + k) * DFF2 + DFF + j]; } }
        H[(size_t)(r0 + lr) * DFF + j] = (f16)(gelu_tanh(g) * v);
    }
}

struct Args { void* in[24]; float* out; unsigned char* ws; int ph_lo, ph_hi; };
__global__ void __launch_bounds__(NTHR, 2) fwd_kernel(Args args) {
    extern __shared__ __attribute__((aligned(16))) unsigned char lds[];
    Frame F;
    F.lds = (LAS unsigned char*)lds; F.MISC = (volatile LAS unsigned*)(F.lds + MISC_OFF);
    F.tid = threadIdx.x; F.lane = F.tid & 63; F.wave = __builtin_amdgcn_readfirstlane(F.tid >> 6);
    F.G = gridDim.x; { const int bx = blockIdx.x; F.vcu = (F.G % 8 == 0) ? (bx % 8) * (F.G / 8) + bx / 8 : bx; }
    F.gw = F.vcu * NWAVES + F.wave; F.ngw = F.G * NWAVES;
    F.ws = args.ws; F.ctl = (gu32*)(args.ws + WS_CTL); F.out = args.out;
    F.x_in = (const float*)args.in[0]; F.mem = (const float*)args.in[1]; F.rel_bias = (const float*)args.in[2];
    for (int u = F.tid; u < (LDS_BYTES - LDSCTL_OFF) / 4; u += NTHR) ((LAS unsigned*)(F.lds + LDSCTL_OFF))[u] = 0u;
    __syncthreads();
    const bool single = (args.ph_hi - args.ph_lo) > 1;
    XcdBarrier bar; bar.bar = (unsigned*)(F.ctl + CW_BAR); bar.x = 0; bar.st = nullptr;
    if (single) bar = xcd_barrier_post((unsigned*)(F.ctl + CW_BAR), F.MISC + 8);
    int ph = 0;
    const int lo = args.ph_lo, hi = args.ph_hi;
#define PHASE_BEGIN if (lo <= ph && ph < hi) { { int t_ = threadIdx.x; asm volatile("" : "+v"(t_)); F.tid = t_; F.lane = t_ & 63; }
#define PHASE_END   if (ph + 1 < hi) xcd_barrier(bar); } ++ph;

    f16* memb = (f16*)(F.ws + WS_MEMB); float* gates = (float*)(F.ws + WS_GATES); f16* xb = (f16*)(F.ws + WS_XB);
    f16* proj = (f16*)(F.ws + WS_BIG); float* Sf = (float*)(F.ws + WS_BIG); f16* hffn = (f16*)(F.ws + WS_BIG);
    f16* hmix = (f16*)(F.ws + WS_HMIX); f16* Pb = (f16*)(F.ws + WS_HMIX); f16* uchunk = (f16*)(F.ws + WS_HMIX);

    PHASE_BEGIN
        for (int l = 0; l < DEPTH; ++l) {
            const LayerW L = layer_w(args.in, F.ws, l);
            transpose_all(F, L.w_in, NIN, DM, (f16*)(L.wb + WL_WIN), NPROJ, [](int n) { return n < 2048 ? n : n + 8; });
            transpose_all(F, L.w_out, DM, DM, (f16*)(L.wb + WL_WOUT), DM, [](int n) { return n; });
            transpose_all(F, L.xa_wkv, 2 * DM, DM, (f16*)(L.wb + WL_WKV), 2 * DM, [](int n) { return n; });
            transpose_all(F, L.xa_wo, DM, DM, (f16*)(L.wb + WL_WO), DM, [](int n) { return n; });
            transpose_all(F, L.w_up, DFF2, DM, (f16*)(L.wb + WL_WUP), DFF2, [](int n) { return n; });
            transpose_all(F, L.w_down, DM, DFF, (f16*)(L.wb + WL_WDN), DM, [](int n) { return n; });
            convert_f16(F, L.xa_wq, (f16*)(L.wb + WL_WQN), (size_t)DM * DM);
            float* Wg = (float*)(L.wb + WL_WG);
            for (int i = F.vcu * NTHR + F.tid; i < 8 * DM; i += F.G * NTHR) { const int c = i / DM, k = i % DM; Wg[i] = L.w_in[(size_t)k * NIN + 2048 + c]; }
        }
        convert_f16(F, F.mem, memb, (size_t)2048 * DM);
        convert_f16(F, F.x_in, xb, (size_t)M * DM);
    PHASE_END

    PHASE_BEGIN
        for (int l = 0; l < DEPTH; ++l) { unsigned char* wb = F.ws + WS_W + (size_t)l * WL_SIZE;
            auto S = pg8::flat_sched(memb, DM, (const f16*)(wb + WL_WKV), DM, 8, 8, 1 << 20, 0);
            pg8::gemm_phase<pg8::EpiF16, decltype(S), false>(F.lds, pg8::Geo{DM, DM, DM}, S, pg8::EpiF16{(f16*)(wb + WL_KV), 2048, 1.f}); }
    PHASE_END
    PHASE_BEGIN
        { unsigned char* w0 = F.ws + WS_W;
          auto S1 = pg8::make_sched(256, [=](int L, pg8::Unit& u) { const int l = L >> 7, r = L & 127, z = r >> 2, pn = r & 3, b = z >> 2, h = z & 3; const unsigned char* wb = w0 + (size_t)l * WL_SIZE;
              u.pm = 0; u.pn = pn; u.a = (const char*)(wb + WL_KV) + ((size_t)b * 256 * 2048 + h * 256) * 2; u.b = (const char*)(wb + WL_WQN) + ((size_t)pn * 256 * DM + h * 256) * 2;
              u.ooff = (long)((size_t)l * (WL_SIZE / 2) + (size_t)b * DM * DM + (size_t)h * 256 * DM); });
          pg8::gemm_phase<pg8::EpiF16, decltype(S1), false>(F.lds, pg8::Geo{2048, DM, 256}, S1, pg8::EpiF16{(f16*)(w0 + WL_GT), DM, 0.0625f});
          auto S2 = pg8::make_sched(256, [=](int L, pg8::Unit& u) { const int l = L >> 7, r = L & 127, z = r >> 2, pm = r & 3, b = z >> 2, h = z & 3; const unsigned char* wb = w0 + (size_t)l * WL_SIZE;
              u.pm = pm; u.pn = 0; u.a = (const char*)(wb + WL_WO) + ((size_t)pm * 256 * DM + h * 256) * 2; u.b = (const char*)(wb + WL_KV) + ((size_t)b * 256 * 2048 + 1024 + h * 256) * 2;
              u.ooff = (long)((size_t)l * (WL_SIZE / 2) + (size_t)b * DM * DM + (size_t)h * 256); });
          pg8::gemm_phase<pg8::EpiF16, decltype(S2), false>(F.lds, pg8::Geo{DM, 2048, 256}, S2, pg8::EpiF16{(f16*)(w0 + WL_VWT), DM, 1.f}); }
    PHASE_END

    for (int l = 0; l < DEPTH; ++l) {
        const LayerW L = layer_w(args.in, F.ws, l);
        const float* xres = (l == 0) ? F.x_in : F.out;
        PHASE_BEGIN
            { auto S = pg8::flat_sched(xb, DM, (const f16*)(L.wb + WL_WIN), DM, M / 256, NPROJ / 256, 1 << 20, 0);
              pg8::gemm_phase<pg8::EpiF16, decltype(S), false>(F.lds, pg8::Geo{DM, DM, DM}, S, pg8::EpiF16{proj, NPROJ, 1.f}); }
            n_gates(F, xb, (const float*)(L.wb + WL_WG), L.ml_i_bias, L.ml_f_bias, gates);
        PHASE_END
        PHASE_BEGIN
            ml::mlstm_agg(F, L, proj, gates, F.ws + WS_AGG);
            sw::swa_phase(F, L, F.rel_bias, proj, hmix, (int)blockIdx.x, F.G);
        PHASE_END
        PHASE_BEGIN
            ml::mlstm_out(F, L, proj, gates, hmix, F.ws + WS_AGG);
        PHASE_END
        PHASE_BEGIN
            { auto S = pg8::flat_sched(hmix, DM, (const f16*)(L.wb + WL_WOUT), DM, M / 256, DM / 256, 1 << 20, 0);
              pg8::gemm_phase<pg8::EpiRes, decltype(S), false>(F.lds, pg8::Geo{DM, DM, DM}, S, pg8::EpiRes{xres, F.out, DM}); }
        PHASE_END
        PHASE_BEGIN
            n_ln(F, F.out, L.ln1_g, L.ln1_b, xb);
        PHASE_END
        PHASE_BEGIN
            { auto S = pg8::flat_sched(xb, DM, (const f16*)(L.wb + WL_GT), DM, M / 256, DM / 256, SEQ / 256, (size_t)DM * DM * 2);
              pg8::gemm_phase<pg8::EpiF32, decltype(S), false>(F.lds, pg8::Geo{DM, DM, DM}, S, pg8::EpiF32{Sf, DM}); }
        PHASE_END
        PHASE_BEGIN
            n_softmax(F, Sf, Pb);
        PHASE_END
        PHASE_BEGIN
            { auto S = pg8::flat_sched(Pb, DM, (const f16*)(L.wb + WL_VWT), DM, M / 256, DM / 256, SEQ / 256, (size_t)DM * DM * 2);
              pg8::gemm_phase<pg8::EpiRes, decltype(S), false>(F.lds, pg8::Geo{DM, DM, DM}, S, pg8::EpiRes{F.out, F.out, DM}); }
        PHASE_END
        PHASE_BEGIN
            n_ln(F, F.out, L.ln2_g, L.ln2_b, xb);
        PHASE_END
        for (int c = 0; c < BATCH; ++c) {
            PHASE_BEGIN
                { auto S = pg8::flat_sched(xb + (size_t)c * SEQ * DM, DM, (const f16*)(L.wb + WL_WUP), DM, SEQ / 256, DFF2 / 256, 1 << 20, 0);
                  pg8::gemm_phase<pg8::EpiF16, decltype(S), false>(F.lds, pg8::Geo{DM, DM, DM}, S, pg8::EpiF16{uchunk, DFF2, 1.f}); }
            PHASE_END
            PHASE_BEGIN
                n_convgelu(F, L, uchunk, c * SEQ, SEQ, hffn);
            PHASE_END
        }
        PHASE_BEGIN
            { auto S = pg8::flat_sched(hffn, DFF, (const f16*)(L.wb + WL_WDN), DFF, M / 256, DM / 256, 1 << 20, 0);
              pg8::gemm_phase<pg8::EpiRes, decltype(S), false>(F.lds, pg8::Geo{DFF, DFF, DFF}, S, pg8::EpiRes{F.out, F.out, DM}); }
        PHASE_END
        PHASE_BEGIN
            n_ln(F, F.out, L.ln3_g, L.ln3_b, xb);
        PHASE_END
    }
    if (single && hi > 1) { if (__hip_atomic_load(F.ctl + CW_BAR + XB_TMO, RLX_AGENT) != 0u && F.vcu == 0 && F.tid < 64) F.out[F.tid] = __builtin_nanf(""); }
}
constexpr int NPHASES = 3 + DEPTH * (11 + 2 * BATCH);

extern "C" void kernel_launch(void* const* d_in, const int* in_sizes, int n_in, void* d_out, int out_size, void* d_ws, size_t ws_size, hipStream_t stream) {
    static int grid = 0;
    if (grid == 0) {
        if (n_in != 24 || out_size != M * DM || ws_size < WS_END) { fprintf(stderr, "kernel_launch: unexpected shapes (n_in %d out %d ws %zu)\n", n_in, out_size, ws_size); grid = -1; return; }
        int dev = 0, cus = 0;
        if (hipGetDevice(&dev) != hipSuccess || hipDeviceGetAttribute(&cus, hipDeviceAttributeMultiprocessorCount, dev) != hipSuccess) { grid = -1; return; }
        if (hipFuncSetAttribute((const void*)fwd_kernel, hipFuncAttributeMaxDynamicSharedMemorySize, LDS_BYTES) != hipSuccess) { fprintf(stderr, "hipFuncSetAttribute failed\n"); grid = -1; return; }
        (void)hipGetLastError();
        grid = cus;
    }
    if (grid < 0) return;
    hipMemsetAsync((char*)d_ws + WS_CTL, 0, CTL_ZERO_BYTES, stream);
    Args a{};
    for (int i = 0; i < 24; ++i) a.in[i] = d_in[i];
    a.out = (float*)d_out; a.ws = (unsigned char*)d_ws;
#ifndef MK_PER_PHASE
    a.ph_lo = 0; a.ph_hi = NPHASES;
    hipLaunchKernelGGL(fwd_kernel, dim3(grid), dim3(NTHR), LDS_BYTES, stream, a);
#else
    for (int p = 0; p < NPHASES; ++p) { a.ph_lo = p; a.ph_hi = p + 1; hipLaunchKernelGGL(fwd_kernel, dim3(grid), dim3(NTHR), LDS_BYTES, stream, a); }
#endif
}
```
